# Optimizing an MI355X kernel written in HIP

```python
import jax, jax.numpy as jnp
from jax import lax
import numpy as np

D_MODEL = 1024
BATCH = 8
SEQ = 4096
DEPTH = 2

GRID_W = 64
CTX_LEN = 256
HEAD_DIM = 64
N_MIXERS = 4
GROUP_HEADS = D_MODEL // (N_MIXERS * HEAD_DIM)
GROUP_WIDTH = GROUP_HEADS * HEAD_DIM
KV_HEADS = GROUP_HEADS // 2
KV_WIDTH = KV_HEADS * HEAD_DIM
Q_BLOCK = 128
WINDOW = 128
ROPE_THETA = 10000.0
GLA_DK = HEAD_DIM // 2
GLA_KW = GROUP_HEADS * GLA_DK
GLA_GATE_RANK = 16
GLA_GATE_TAU = 16.0
GLA_CHUNK = 64
MLSTM_CHUNK = 64
D_FF = 4 * D_MODEL
N_MOD = 6
EPS = 1e-6
NEG = -1e30
IN_SPLITS = (GROUP_WIDTH, KV_WIDTH, KV_WIDTH,
             GROUP_WIDTH, KV_WIDTH, KV_WIDTH,
             GLA_KW, GLA_KW, GROUP_WIDTH, GROUP_WIDTH, 2 * GLA_GATE_RANK,
             GROUP_WIDTH, GROUP_WIDTH, GROUP_WIDTH, GROUP_WIDTH,
             2 * GROUP_HEADS, 2 * GROUP_HEADS)
IN_WIDTH = sum(IN_SPLITS)

kernel_name = 'hybrid_parallel_heads_dit_block'


def rms_norm(x, g):
    xf = x.astype(jnp.float32)
    y = xf * lax.rsqrt(jnp.mean(xf * xf, axis=-1, keepdims=True) + EPS)
    return (y * g.astype(jnp.float32)).astype(x.dtype)


def heads(a, dim=HEAD_DIM):
    return a.reshape(a.shape[:-1] + (-1, dim))


def _flip(a):
    return jnp.flip(a, axis=1)


def _ident(a):
    return a


def axial_rope(n_tokens):
    rows = n_tokens // GRID_W
    row = jnp.repeat(jnp.arange(rows, dtype=jnp.float32), GRID_W)
    col = jnp.tile(jnp.arange(GRID_W, dtype=jnp.float32), rows)
    n_freq = HEAD_DIM // 4
    inv = ROPE_THETA ** (-jnp.arange(n_freq, dtype=jnp.float32) / n_freq)
    ang = jnp.concatenate([row[:, None] * inv, col[:, None] * inv], axis=-1)
    return jnp.cos(ang), jnp.sin(ang)


def apply_rope(x, cos, sin):
    xf = x.astype(jnp.float32)
    x1, x2 = xf[..., 0::2], xf[..., 1::2]
    c, s = cos[:, None, :], sin[:, None, :]
    y = jnp.stack([x1 * c - x2 * s, x1 * s + x2 * c], axis=-1).reshape(x.shape)
    return y.astype(x.dtype)


def context_attention(q, k, v, sink):
    B_, L, H, d = q.shape
    G = k.shape[2]
    R = H // G
    qg = q.reshape(B_, L, G, R, d)
    s = jnp.einsum('blgrd,bmgd->bgrlm', qg, k, preferred_element_type=jnp.float32) * d ** -0.5
    if sink is not None:
        s_sink = jnp.broadcast_to(sink.astype(jnp.float32).reshape(1, G, R, 1, 1), s.shape[:-1] + (1,))
        s = jnp.concatenate([s, s_sink], axis=-1)
    w = jax.nn.softmax(s, axis=-1)[..., :L]
    o = jnp.einsum('bgrlm,bmgd->blgrd', w.astype(v.dtype), v)
    return o.reshape(B_, L, H * d)


def global_block_attention(q, k, v, k_c, v_c):
    B_, S, H, d = q.shape
    G = k.shape[2]
    R = H // G
    nb = S // Q_BLOCK
    scale = d ** -0.5
    qb = q.reshape(B_, nb, Q_BLOCK, G, R, d).transpose(1, 0, 2, 3, 4, 5)

    def one_block(qi):
        s_lat = jnp.einsum('bqgrd,bkgd->bgrqk', qi, k, preferred_element_type=jnp.float32) * scale
        s_ctx = jnp.einsum('bqgrd,bcgd->bgrqc', qi, k_c, preferred_element_type=jnp.float32) * scale
        w = jax.nn.softmax(jnp.concatenate([s_lat, s_ctx], axis=-1), axis=-1).astype(v.dtype)
        return (jnp.einsum('bgrqk,bkgd->bqgrd', w[..., :S], v)
                + jnp.einsum('bgrqc,bcgd->bqgrd', w[..., S:], v_c))

    o = lax.map(one_block, qb)
    return o.transpose(1, 0, 2, 3, 4, 5).reshape(B_, S, H * d)


def window_block_attention(q, k, v, k_c, v_c, sink):
    B_, S, H, d = q.shape
    G = k.shape[2]
    R = H // G
    L = k_c.shape[1]
    nb = S // Q_BLOCK
    scale = d ** -0.5
    pad = ((0, 0), (Q_BLOCK, Q_BLOCK), (0, 0), (0, 0))
    kp = jnp.pad(k, pad).reshape(B_, nb + 2, Q_BLOCK, G, d)
    vp = jnp.pad(v, pad).reshape(B_, nb + 2, Q_BLOCK, G, d)
    kw = jnp.concatenate([kp[:, :-2], kp[:, 1:-1], kp[:, 2:]], axis=2)
    vw = jnp.concatenate([vp[:, :-2], vp[:, 1:-1], vp[:, 2:]], axis=2)
    qb = q.reshape(B_, nb, Q_BLOCK, G, R, d)
    s_win = jnp.einsum('bnqgrd,bnkgd->bngrqk', qb, kw, preferred_element_type=jnp.float32) * scale
    qpos = jnp.arange(nb)[:, None] * Q_BLOCK + jnp.arange(Q_BLOCK)[None, :]
    kpos = jnp.arange(nb)[:, None] * Q_BLOCK - Q_BLOCK + jnp.arange(3 * Q_BLOCK)[None, :]
    ok = ((jnp.abs(qpos[:, :, None] - kpos[:, None, :]) <= WINDOW)
          & (kpos >= 0)[:, None, :] & (kpos < S)[:, None, :])
    s_win = jnp.where(ok[None, :, None, None], s_win, NEG)
    s_ctx = jnp.einsum('bnqgrd,bcgd->bngrqc', qb, k_c, preferred_element_type=jnp.float32) * scale
    s_sink = jnp.broadcast_to(sink.astype(jnp.float32).reshape(1, 1, G, R, 1, 1), s_ctx.shape[:-1] + (1,))
    w = jax.nn.softmax(jnp.concatenate([s_win, s_ctx, s_sink], axis=-1), axis=-1).astype(v.dtype)
    K3 = 3 * Q_BLOCK
    o = (jnp.einsum('bngrqk,bnkgd->bnqgrd', w[..., :K3], vw)
         + jnp.einsum('bngrqc,bcgd->bnqgrd', w[..., K3:K3 + L], v_c))
    return o.reshape(B_, S, H * d)


def gla_scan(q, k, v, log_a, state):
    B_, T, H, _ = q.shape
    dv = v.shape[-1]
    nc = T // GLA_CHUNK
    tri = jnp.tril(jnp.ones((GLA_CHUNK, GLA_CHUNK), dtype=bool))

    def chunks(a):
        return a.astype(jnp.float32).reshape(B_, nc, GLA_CHUNK, H, a.shape[-1]).transpose(1, 0, 3, 2, 4)

    def step(S, inp):
        qc, kc, vc, la = inp
        b = jnp.cumsum(la, axis=2)
        rel = jnp.where(tri[:, :, None], b[:, :, :, None, :] - b[:, :, None, :, :], -jnp.inf)
        scores = jnp.einsum('bhtd,bhsd,bhtsd->bhts', qc, kc, jnp.exp(rel))
        o = (jnp.einsum('bhts,bhsv->bhtv', scores, vc)
             + jnp.einsum('bhtd,bhdv->bhtv', qc * jnp.exp(b), S))
        b_end = b[:, :, -1:, :]
        S = (jnp.exp(b_end[:, :, 0, :])[..., None] * S
             + jnp.einsum('bhsd,bhsv->bhdv', kc * jnp.exp(b_end - b), vc))
        return S, o

    S, o = lax.scan(step, state, (chunks(q), chunks(k), chunks(v), chunks(log_a)))
    return o.transpose(1, 0, 3, 2, 4).reshape(B_, T, H, dv), S


def mlstm_scan(q, k, v, i_pre, log_f, state):
    B_, T, H, _ = q.shape
    dv = v.shape[-1]
    nc = T // MLSTM_CHUNK
    tri = jnp.tril(jnp.ones((MLSTM_CHUNK, MLSTM_CHUNK), dtype=bool))

    def chunks4(a):
        return a.astype(jnp.float32).reshape(B_, nc, MLSTM_CHUNK, H, a.shape[-1]).transpose(1, 0, 3, 2, 4)

    def chunks3(a):
        return a.astype(jnp.float32).reshape(B_, nc, MLSTM_CHUNK, H).transpose(1, 0, 3, 2)

    def step(carry, inp):
        C, n, m = carry
        qc, kc, vc, ic, fc = inp
        F = jnp.cumsum(fc, axis=-1)
        logw = jnp.where(tri, F[..., :, None] - F[..., None, :] + ic[..., None, :], -jnp.inf)
        log_inter = F + m[..., None]
        m_t = jnp.maximum(log_inter, jnp.max(logw, axis=-1))
        w = jnp.exp(logw - m_t[..., None])
        w_inter = jnp.exp(log_inter - m_t)
        qk = jnp.einsum('bhtd,bhsd->bhts', qc, kc) * w
        num = (jnp.einsum('bhts,bhsv->bhtv', qk, vc)
               + w_inter[..., None] * jnp.einsum('bhtd,bhdv->bhtv', qc, C))
        den = jnp.sum(qk, axis=-1) + w_inter * jnp.einsum('bhtd,bhd->bht', qc, n)
        h = num / jnp.maximum(jnp.abs(den), jnp.exp(-m_t))[..., None]
        F_end = F[..., -1]
        log_end = F_end[..., None] - F + ic
        m_new = jnp.maximum(F_end + m, jnp.max(log_end, axis=-1))
        w_end = jnp.exp(log_end - m_new[..., None])
        decay = jnp.exp(F_end + m - m_new)
        C = decay[..., None, None] * C + jnp.einsum('bhs,bhsd,bhsv->bhdv', w_end, kc, vc)
        n = decay[..., None] * n + jnp.einsum('bhs,bhsd->bhd', w_end, kc)
        return (C, n, m_new), h

    state, h = lax.scan(step, state, (chunks4(q), chunks4(k), chunks4(v), chunks3(i_pre), chunks3(log_f)))
    return h.transpose(1, 0, 3, 2, 4).reshape(B_, T, H, dv), state


def mixer_global_gqa(z, zc, p, cos, sin, ctx_out):
    q = apply_rope(rms_norm(heads(z[0]), p['g_q_a']), cos, sin)
    k = apply_rope(rms_norm(heads(z[1]), p['g_k_a']), cos, sin)
    v = heads(z[2])
    k_c = rms_norm(heads(zc[1]), p['g_k_a'])
    v_c = heads(zc[2])
    o = global_block_attention(q, k, v, k_c, v_c)
    o_c = context_attention(rms_norm(heads(zc[0]), p['g_q_a']), k_c, v_c, None) if ctx_out else None
    return o, o_c


def mixer_window_gqa(z, zc, p, cos, sin, ctx_out):
    q = apply_rope(rms_norm(heads(z[0]), p['g_q_b']), cos, sin)
    k = apply_rope(rms_norm(heads(z[1]), p['g_k_b']), cos, sin)
    v = heads(z[2])
    k_c = rms_norm(heads(zc[1]), p['g_k_b'])
    v_c = heads(zc[2])
    o = window_block_attention(q, k, v, k_c, v_c, p['sink_b'])
    o_c = context_attention(rms_norm(heads(zc[0]), p['g_q_b']), k_c, v_c, p['sink_b']) if ctx_out else None
    return o, o_c


def mixer_gla(z, zc, p):
    def prep(parts):
        q, k, v, r, g = parts
        return (heads(q, GLA_DK) * GLA_DK ** -0.5, heads(k, GLA_DK), heads(v), heads(r), g)

    lat, ctx = prep(z), prep(zc)

    def log_decay(g, d):
        g_d = g[..., d * GLA_GATE_RANK:(d + 1) * GLA_GATE_RANK]
        pre = g_d @ p['w_gla_gate'][d] + p['b_gla_gate'][d]
        return heads(jax.nn.log_sigmoid(pre.astype(jnp.float32)) / GLA_GATE_TAU, GLA_DK)

    B_ = lat[0].shape[0]
    outs, outs_c = [], []
    for d in range(2):
        fl = _flip if d == 1 else _ident
        s0 = jnp.zeros((B_, GROUP_HEADS, GLA_DK, HEAD_DIM), jnp.float32)
        o_c, s_ctx = gla_scan(fl(ctx[0]), fl(ctx[1]), fl(ctx[2]), fl(log_decay(ctx[4], d)), s0)
        o_l, _ = gla_scan(fl(lat[0]), fl(lat[1]), fl(lat[2]), fl(log_decay(lat[4], d)), s_ctx)
        outs.append(fl(o_l))
        outs_c.append(fl(o_c))

    def finish(o, r):
        y = rms_norm(o, p['g_gla_out']) * jax.nn.silu(r.astype(jnp.float32))
        return y.reshape(y.shape[:2] + (GROUP_WIDTH,)).astype(r.dtype)

    return finish(outs[0] + outs[1], lat[3]), finish(outs_c[0] + outs_c[1], ctx[3])


def mixer_mlstm(z, zc, p):
    def prep(parts):
        q, k, v, o, i_pre, f_pre = parts
        return (heads(q), heads(k) * HEAD_DIM ** -0.5, heads(v), heads(o), i_pre, f_pre)

    lat, ctx = prep(z), prep(zc)

    def gates(parts, d):
        sl = slice(d * GROUP_HEADS, (d + 1) * GROUP_HEADS)
        ig = parts[4][..., sl].astype(jnp.float32) + p['b_mlstm_i'][d].astype(jnp.float32)
        lf = jax.nn.log_sigmoid(parts[5][..., sl].astype(jnp.float32) + p['b_mlstm_f'][d].astype(jnp.float32))
        return ig, lf

    B_ = lat[0].shape[0]
    outs, outs_c = [], []
    for d in range(2):
        fl = _flip if d == 1 else _ident
        st0 = (jnp.zeros((B_, GROUP_HEADS, HEAD_DIM, HEAD_DIM), jnp.float32),
               jnp.zeros((B_, GROUP_HEADS, HEAD_DIM), jnp.float32),
               jnp.zeros((B_, GROUP_HEADS), jnp.float32))
        ig_c, lf_c = gates(ctx, d)
        ig_l, lf_l = gates(lat, d)
        h_c, st_ctx = mlstm_scan(fl(ctx[0]), fl(ctx[1]), fl(ctx[2]), fl(ig_c), fl(lf_c), st0)
        h_l, _ = mlstm_scan(fl(lat[0]), fl(lat[1]), fl(lat[2]), fl(ig_l), fl(lf_l), st_ctx)
        outs.append(fl(h_l))
        outs_c.append(fl(h_c))

    def finish(h, o):
        y = jax.nn.sigmoid(o.astype(jnp.float32)) * rms_norm(h, p['g_mlstm_out'])
        return y.reshape(y.shape[:2] + (GROUP_WIDTH,)).astype(o.dtype)

    return finish(outs[0] + outs[1], lat[3]), finish(outs_c[0] + outs_c[1], ctx[3])


def squared_relu_mlp(h, w1, w2):
    return jnp.square(jax.nn.relu(h @ w1)) @ w2


def hybrid_layer(x, xc, mod, mod_c, p, cos, sin, ctx_out):
    sh1, sc1, ga1, sh2, sc2, ga2 = jnp.split(mod[:, None, :], N_MOD, axis=-1)
    sh1c, sc1c, ga1c, sh2c, sc2c, ga2c = jnp.split(mod_c, N_MOD, axis=-1)
    offs = np.cumsum(IN_SPLITS)[:-1].tolist()
    h = rms_norm(x, p['g_norm1']) * (1.0 + sc1) + sh1
    hc = rms_norm(xc, p['g_norm1']) * (1.0 + sc1c) + sh1c
    z = jnp.split(h @ p['w_in'], offs, axis=-1)
    zc = jnp.split(hc @ p['w_in'], offs, axis=-1)
    o_a, oc_a = mixer_global_gqa(z[0:3], zc[0:3], p, cos, sin, ctx_out)
    o_b, oc_b = mixer_window_gqa(z[3:6], zc[3:6], p, cos, sin, ctx_out)
    o_c, oc_c = mixer_gla(z[6:11], zc[6:11], p)
    o_d, oc_d = mixer_mlstm(z[11:17], zc[11:17], p)
    y = jnp.concatenate([o_a, o_b, o_c, o_d], axis=-1) @ p['w_out']
    x = x + ga1 * y
    x = x + ga2 * squared_relu_mlp(rms_norm(x, p['g_norm2']) * (1.0 + sc2) + sh2, p['w_mlp1'], p['w_mlp2'])
    if ctx_out:
        yc = jnp.concatenate([oc_a, oc_b, oc_c, oc_d], axis=-1) @ p['w_out']
        xc = xc + ga1c * yc
        xc = xc + ga2c * squared_relu_mlp(rms_norm(xc, p['g_norm2']) * (1.0 + sc2c) + sh2c, p['w_mlp1'], p['w_mlp2'])
    return x, xc


def setup_inputs(seed: int = 0) -> dict:
    key = jax.random.key(seed)
    ks = jax.random.split(key, 24)
    f32 = jnp.float32
    nrm = lambda k, shape, s: jax.random.normal(k, shape, f32) * s
    D = D_MODEL
    return {
        'x': nrm(ks[0], (BATCH, SEQ, D), 1.0),
        'c': nrm(ks[1], (BATCH, D), 1.0),
        'ctx': nrm(ks[2], (BATCH, CTX_LEN, D), 1.0),
        'c_ctx': nrm(ks[3], (D,), 1.0),
        'w_mod': nrm(ks[4], (DEPTH, D, N_MOD * D), 0.5 * D ** -0.5),
        'b_mod': nrm(ks[5], (DEPTH, N_MOD * D), 0.02),
        'g_norm1': 1.0 + nrm(ks[6], (DEPTH, D), 0.02),
        'g_norm2': 1.0 + nrm(ks[7], (DEPTH, D), 0.02),
        'w_in': nrm(ks[8], (DEPTH, D, IN_WIDTH), D ** -0.5),
        'g_q_a': 1.0 + nrm(ks[9], (DEPTH, HEAD_DIM), 0.02),
        'g_k_a': 1.0 + nrm(ks[10], (DEPTH, HEAD_DIM), 0.02),
        'g_q_b': 1.0 + nrm(ks[11], (DEPTH, HEAD_DIM), 0.02),
        'g_k_b': 1.0 + nrm(ks[12], (DEPTH, HEAD_DIM), 0.02),
        'sink_b': nrm(ks[13], (DEPTH, GROUP_HEADS), 0.5),
        'w_gla_gate': nrm(ks[14], (DEPTH, 2, GLA_GATE_RANK, GLA_KW), GLA_GATE_RANK ** -0.5),
        'b_gla_gate': nrm(ks[15], (DEPTH, 2, GLA_KW), 0.1),
        'g_gla_out': 1.0 + nrm(ks[16], (DEPTH, HEAD_DIM), 0.02),
        'b_mlstm_i': nrm(ks[17], (DEPTH, 2, GROUP_HEADS), 0.1),
        'b_mlstm_f': 3.0 + nrm(ks[18], (DEPTH, 2, GROUP_HEADS), 0.5),
        'g_mlstm_out': 1.0 + nrm(ks[19], (DEPTH, HEAD_DIM), 0.02),
        'w_out': nrm(ks[20], (DEPTH, D, D), D ** -0.5),
        'w_mlp1': nrm(ks[21], (DEPTH, D, D_FF), D ** -0.5),
        'w_mlp2': nrm(ks[22], (DEPTH, D_FF, D), D_FF ** -0.5),
    }


def reference(x, c, ctx, c_ctx, w_mod, b_mod, g_norm1, g_norm2, w_in, g_q_a, g_k_a, g_q_b, g_k_b, sink_b,
              w_gla_gate, b_gla_gate, g_gla_out, b_mlstm_i, b_mlstm_f, g_mlstm_out, w_out, w_mlp1, w_mlp2):
    cos, sin = axial_rope(x.shape[1])
    s_c = jax.nn.silu(c)
    s_cc = jax.nn.silu(c_ctx)
    xc = ctx
    for l in range(DEPTH):
        mod = s_c @ w_mod[l] + b_mod[l]
        mod_c = s_cc @ w_mod[l] + b_mod[l]
        p = {'g_norm1': g_norm1[l], 'g_norm2': g_norm2[l], 'w_in': w_in[l],
             'g_q_a': g_q_a[l], 'g_k_a': g_k_a[l], 'g_q_b': g_q_b[l], 'g_k_b': g_k_b[l], 'sink_b': sink_b[l],
             'w_gla_gate': w_gla_gate[l], 'b_gla_gate': b_gla_gate[l], 'g_gla_out': g_gla_out[l],
             'b_mlstm_i': b_mlstm_i[l], 'b_mlstm_f': b_mlstm_f[l], 'g_mlstm_out': g_mlstm_out[l],
             'w_out': w_out[l], 'w_mlp1': w_mlp1[l], 'w_mlp2': w_mlp2[l]}
        x, xc = hybrid_layer(x, xc, mod, mod_c, p, cos, sin, l < DEPTH - 1)
    return x
```

```cpp
#include <hip/hip_runtime.h>
#include <hip/hip_cooperative_groups.h>
#include <cstdio>
#include <cstdint>
namespace cg = cooperative_groups;

#define DI __device__ __forceinline__
#define LAS __attribute__((address_space(3)))
typedef unsigned short bf16_t;
typedef short bf16x8 __attribute__((ext_vector_type(8)));
typedef float f32x4 __attribute__((ext_vector_type(4)));
typedef float f32x2 __attribute__((ext_vector_type(2)));
typedef float f32x16 __attribute__((ext_vector_type(16)));
typedef unsigned u32x4 __attribute__((ext_vector_type(4)));
typedef unsigned u32x2 __attribute__((ext_vector_type(2)));
typedef __bf16 bf2_t __attribute__((ext_vector_type(2)));

constexpr int D = 1024, NB = 8, SEQ = 4096, CTX = 256, TT = SEQ + CTX  , MROWS = NB * TT  ;
constexpr int ZW = 3072, FF = 4096, NTB = TT / 64  , INW = 2864;
constexpr float EPS = 1e-6f;
constexpr int C_QA = 0, C_KA = 256, C_VA = 384, C_QB = 512, C_KB = 768, C_VB = 896;
constexpr int C_QC = 1024, C_KC = 1152, C_VC = 1280, C_RC = 1536, C_GC = 1792;
constexpr int C_QD = 1824, C_KD = 2080, C_VD = 2336, C_OD = 2592, C_ID = 2848;
constexpr int LDS_BYTES = 147456;

constexpr size_t al256(size_t x) { return (x + 255) & ~(size_t)255; }
constexpr size_t WS_WIN = 0;
constexpr size_t WS_WOUT = WS_WIN + (size_t)2 * ZW * D * 2;
constexpr size_t WS_W1 = WS_WOUT + (size_t)2 * D * D * 2;
constexpr size_t WS_W2 = WS_W1 + (size_t)2 * FF * D * 2;
constexpr size_t WS_MOD = WS_W2 + (size_t)2 * FF * D * 2;
constexpr size_t WS_XC = WS_MOD + al256((size_t)2 * 9 * 6 * D * 4);
constexpr size_t WS_Z = WS_XC + (size_t)NB * CTX * D * 4;
constexpr size_t WS_O = WS_Z + (size_t)MROWS * ZW * 2;
constexpr size_t WS_H = WS_O + (size_t)MROWS * D * 2;
constexpr size_t WS_U1 = WS_Z;
constexpr size_t WS_SLAB = WS_H + (size_t)MROWS * D * 2;
constexpr size_t WS_BG = WS_H;
constexpr size_t WS_UGD = WS_BG + (size_t)MROWS * 256 * 4;
constexpr size_t WS_UGC = WS_UGD + (size_t)64 * NTB * 4096 * 2;
constexpr size_t WS_ZTC = WS_UGC + (size_t)64 * NTB * 2048 * 2;
constexpr size_t WS_ZTD = WS_ZTC + (size_t)NB * 384 * TT * 2;
constexpr size_t WS_VTAB = WS_ZTD + (size_t)NB * 512 * TT * 2;
constexpr size_t WS_GATE = WS_VTAB + (size_t)NB * 256 * TT * 2;
constexpr size_t WS_FG = WS_GATE + (size_t)MROWS * 48 * 4;
constexpr size_t WS_IG = WS_FG + (size_t)MROWS * 8 * 4;
constexpr size_t WS_DGC = WS_IG + (size_t)MROWS * 8 * 4;
constexpr size_t WS_NGD = WS_DGC + (size_t)64 * NTB * 32 * 4;
constexpr size_t WS_DGD = WS_NGD + (size_t)64 * NTB * 64 * 4;
constexpr size_t WS_BAR = WS_DGD + al256((size_t)64 * NTB * 4);
constexpr size_t WS_END = WS_BAR + 16384;
static_assert(WS_GATE >= WS_H + (size_t)MROWS * D * 2, "GATE must not alias H");
static_assert(WS_END <= (size_t)536870912, "workspace budget");

struct Params {
    const float *x, *c, *ctx, *c_ctx, *w_mod, *b_mod, *g_norm1, *g_norm2, *w_in, *g_q_a, *g_k_a, *g_q_b, *g_k_b, *sink_b,
        *w_gla_gate, *b_gla_gate, *g_gla_out, *b_mlstm_i, *b_mlstm_f, *g_mlstm_out, *w_out, *w_mlp1, *w_mlp2;
    float* out; unsigned char* ws;
};
struct KP : Params { int wv; };

DI unsigned pk2(float lo, float hi) { f32x2 v = {lo, hi}; bf2_t r = __builtin_convertvector(v, bf2_t); return __builtin_bit_cast(unsigned, r); }
DI bf16_t f2bf(float x) { return (bf16_t)(pk2(x, 0.f) & 0xffffu); }
DI float bflo(unsigned u) { return __uint_as_float(u << 16); }
DI float bfhi(unsigned u) { return __uint_as_float(u & 0xffff0000u); }
DI float bf2f(bf16_t h) { return __uint_as_float((unsigned)h << 16); }
DI float logsig(float x) { return fminf(x, 0.f) - __logf(1.f + __expf(-fabsf(x))); }
DI int crow(int i, int h) { return (i & 3) + 8 * (i >> 2) + 4 * h; }
#define MFMA32(a, b, c) __builtin_amdgcn_mfma_f32_32x32x16_bf16((a), (b), (c), 0, 0, 0)
DI bf16x8 as_bf8(u32x4 v) { return __builtin_bit_cast(bf16x8, v); }
DI f32x16 zero16() { f32x16 z;
#pragma unroll
    for (int i = 0; i < 16; ++i) z[i] = 0.f; return z; }
DI bf16x8 pack8(const f32x16& x, int s) {
    u32x4 p; p.x = pk2(x[8 * s], x[8 * s + 1]); p.y = pk2(x[8 * s + 2], x[8 * s + 3]); p.z = pk2(x[8 * s + 4], x[8 * s + 5]); p.w = pk2(x[8 * s + 6], x[8 * s + 7]);
    return as_bf8(p);
}
DI int otid(int wv) { int l; asm volatile("v_mbcnt_lo_u32_b32 %0, -1, 0\n\tv_mbcnt_hi_u32_b32 %0, -1, %0" : "=v"(l)); return wv * 64 + l; }
DI int rot(int bx, int k, int G) { int r = bx + k; while (r >= G) r -= G; return r; }
typedef short s16x4 __attribute__((ext_vector_type(4)));
DI s16x4 trr(const LAS bf16_t* p) { return __builtin_amdgcn_ds_read_tr16_b64_v4i16((LAS s16x4*)p); }
DI bf16x8 cat4(s16x4 a, s16x4 b) { return __builtin_shufflevector(a, b, 0, 1, 2, 3, 4, 5, 6, 7); }
DI u32x4 ldg16(const void* p) { return *(const u32x4*)p; }
DI u32x2 ldg8(const void* p) { return *(const u32x2*)p; }

DI const float* xin_tile(const Params& P, int b, int tl  ) { return tl == 0 ? P.ctx + (size_t)b * CTX * D : P.x + ((size_t)b * SEQ + (size_t)(tl - 1) * 256) * D; }
DI float* xst_tile(const Params& P, int b, int tl) { return tl == 0 ? (float*)(P.ws + WS_XC) + (size_t)b * CTX * D : P.out + ((size_t)b * SEQ + (size_t)(tl - 1) * 256) * D; }

namespace pg8 {
constexpr int BM = 256, BK = 64, HALF = 128, HTB = HALF * BK * 2, STAGE_BYTES = 8 * HTB, NXCD = 8, WGM = 8;
DI int lds_byte(int r, int c) { const int st = (r >> 4) * 2 + (c >> 5), rr = r & 15, cc = c & 31, ob = rr * 64 + cc * 2; return st * 1024 + (ob ^ (((ob >> 9) & 1) << 5)); }
DI void stage_rc(int b, int& R, int& C) { const int st = b / 1024, sb = b % 1024, swz = sb ^ (((sb >> 9) & 1) << 5); R = (st >> 1) * 16 + swz / 64; C = (st & 1) * 32 + (swz % 64) / 2; }
DI int perm32(int rho) { const int n = rho >> 4, i = rho & 15; return 8 * (i >> 2) + 4 * n + (i & 3); }
struct Unit { int pm, pn, kofs, nt, split, sl; };
struct Gemm { const bf16_t* A; const bf16_t* Bt; int K; };
struct Order {
    int nM, nN, nwg, G, c, skip, ns, K;
    DI void init(int nN_, int G_, int c_, int skip_, int K_, int ns_ = 0) { skip = skip_; nM = skip_ ? 128 : 136; nN = nN_; nwg = nM * nN; G = G_; c = c_; ns = ns_; K = K_; }
    DI bool next(int i, Unit& u) const {
        const long L = (long)i * G + c;
        u.kofs = 0; u.nt = K / BK; u.split = 0; u.sl = 0;
        if (L >= nwg) { if (ns == 0) return false; const int j = (int)(L - nwg); if (j >= 8 * nN * ns) return false;
            const int sl = j % ns, cu = j / ns; u.pm = (cu / nN) * 17; u.pn = cu % nN; u.nt = K / BK / ns; u.kofs = sl * (K / ns); u.split = 1; u.sl = sl; return true; }
        int wgid = (int)L; { const int q = nwg / NXCD, r = nwg % NXCD, xcd = wgid % NXCD, off = wgid / NXCD; wgid = (xcd < r ? xcd * (q + 1) : r * (q + 1) + (xcd - r) * q) + off; }
        const int nig = WGM * nN, gid = wgid / nig, fm = gid * WGM, gsz = (nM - fm) < WGM ? (nM - fm) : WGM;
        int pm = fm + ((wgid % nig) % gsz); u.pn = (wgid % nig) / gsz;
        u.pm = skip ? pm + pm / 16 + 1 : pm; return true;
    }
};

template <class Epi>
DI void gemm_phase(LAS unsigned char* lds, const Gemm g, const Order& S, const Epi& E, const int wv) {
    const int tid = otid(wv), wid = wv, lane = tid & 63, wr = wid >> 2, wc = wid & 3, fr = lane & 15, fq = lane >> 4;
    const int K = g.K;
    unsigned voffA[2], voffB[2];
#pragma unroll
    for (int i = 0; i < 2; ++i) { int R, C; stage_rc(tid * 16 + i * 8192, R, C); const int Rb = Epi::PERM ? ((R & ~31) + perm32(R & 31)) : R;
        voffA[i] = (unsigned)(R * K + C) * 2u; voffB[i] = (unsigned)(Rb * K + C) * 2u; }
    const size_t kstep = (size_t)(BK * 2);
    const size_t hstep = (size_t)HALF * K * 2;
    const size_t tstep = 2 * hstep;
    const unsigned ldsw = (unsigned)wid * 1024u;
    const int aoff = lds_byte(wr * 64 + fr, fq * 8), boff = lds_byte(wc * 32 + fr, fq * 8);
#define PG8_SA(b, h) (((b) * 2 + (h)) * HTB)
#define PG8_SB(b, h) ((4 + (b) * 2 + (h)) * HTB)
#define PG8_STAGE(bufoff, gbase, voff) do { _Pragma("unroll") for (int _i = 0; _i < 2; ++_i) \
        __builtin_amdgcn_global_load_lds((const unsigned*)((const char*)(gbase) + (voff)[_i]), (LAS unsigned*)(lds + (bufoff) + ldsw + _i * 8192), 16, 0, 0); } while (0)
#define PG8_LDA(dst, b, h) do { _Pragma("unroll") for (int m = 0; m < 4; ++m) _Pragma("unroll") for (int k = 0; k < 2; ++k) dst[m][k] = *(const LAS bf16x8*)(lds + PG8_SA(b, h) + aoff + m * 2048 + k * 1024); } while (0)
#define PG8_LDB(dst, b, h) do { _Pragma("unroll") for (int n = 0; n < 2; ++n) _Pragma("unroll") for (int k = 0; k < 2; ++k) dst[n][k] = *(const LAS bf16x8*)(lds + PG8_SB(b, h) + boff + n * 2048 + k * 1024); } while (0)
#define PG8_MMA(ai, bj, At, Bt) do { __builtin_amdgcn_s_setprio(1); _Pragma("unroll") for (int m = 0; m < 4; ++m) _Pragma("unroll") for (int n = 0; n < 2; ++n) _Pragma("unroll") for (int k = 0; k < 2; ++k) \
        acc[ai][bj][m][n] = __builtin_amdgcn_mfma_f32_16x16x32_bf16(Bt[n][k], At[m][k], acc[ai][bj][m][n], 0, 0, 0); __builtin_amdgcn_s_setprio(0); } while (0)
#define PG8_WAIT_V(n) asm volatile("s_waitcnt vmcnt(" #n ")" ::: "memory")
#define PG8_WAIT_L(n) asm volatile("s_waitcnt lgkmcnt(" #n ")" ::: "memory")
#define PG8_BAR __builtin_amdgcn_s_barrier()
#define PG8_SCHED __builtin_amdgcn_sched_barrier(0)
    Unit cur, nxt; int ui = 0;
    if (!S.next(0, cur)) return;
    f32x4 acc[2][2][4][2];
#pragma unroll
    for (int a = 0; a < 2; ++a)
#pragma unroll
        for (int b = 0; b < 2; ++b)
#pragma unroll
            for (int m = 0; m < 4; ++m)
#pragma unroll
                for (int n = 0; n < 2; ++n) acc[a][b][m][n] = (f32x4){0.f, 0.f, 0.f, 0.f};
    bf16x8 At[4][2], B0[2][2], B1[2][2];
    const char* cA = (const char*)g.A + (size_t)cur.pm * tstep + (size_t)cur.kofs * 2; const char* cB = (const char*)g.Bt + (size_t)cur.pn * tstep + (size_t)cur.kofs * 2;
    PG8_STAGE(PG8_SB(0, 0), cB, voffB); PG8_STAGE(PG8_SB(0, 1), cB + hstep, voffB); PG8_STAGE(PG8_SA(0, 0), cA, voffA); PG8_STAGE(PG8_SA(0, 1), cA + hstep, voffA);
    if (wr == 1) PG8_BAR;
    PG8_WAIT_V(2); PG8_BAR;
    PG8_STAGE(PG8_SB(1, 0), cB + kstep, voffB); PG8_STAGE(PG8_SA(1, 0), cA + kstep, voffA); PG8_STAGE(PG8_SB(1, 1), cB + hstep + kstep, voffB);
    PG8_WAIT_V(6); PG8_BAR;
    for (;;) {
        const bool has_next = S.next(ui + 1, nxt);
        const char* nA = has_next ? (const char*)g.A + (size_t)nxt.pm * tstep + (size_t)nxt.kofs * 2 : cA; const char* nB = has_next ? (const char*)g.Bt + (size_t)nxt.pn * tstep + (size_t)nxt.kofs * 2 : cB;
        const int nt = cur.nt;
        for (int t = 0; t < nt; t += 2) {
            const bool last = (t == nt - 2);
            const char* a1 = cA + (size_t)(t + 1) * kstep;
            const char* a2 = last ? nA : cA + (size_t)(t + 2) * kstep; const char* b2 = last ? nB : cB + (size_t)(t + 2) * kstep;
            const char* a3 = a2 + kstep; const char* b3 = b2 + kstep;
            PG8_LDB(B0, 0, 0); PG8_LDB(B1, 0, 1); PG8_SCHED; PG8_LDA(At, 0, 0); PG8_STAGE(PG8_SA(1, 1), a1 + hstep, voffA);
            PG8_WAIT_V(8); PG8_WAIT_L(0); PG8_BAR; PG8_MMA(0, 0, At, B0); PG8_MMA(0, 1, At, B1); PG8_BAR; PG8_SCHED;
            PG8_LDA(At, 0, 1); PG8_STAGE(PG8_SB(0, 0), b2, voffB); PG8_STAGE(PG8_SB(0, 1), b2 + hstep, voffB); PG8_STAGE(PG8_SA(0, 0), a2, voffA);
            PG8_WAIT_V(8); PG8_WAIT_L(0); PG8_BAR; PG8_MMA(1, 0, At, B0); PG8_MMA(1, 1, At, B1); PG8_BAR; PG8_SCHED;
            PG8_LDB(B0, 1, 0); PG8_LDB(B1, 1, 1); PG8_SCHED; PG8_LDA(At, 1, 0); PG8_STAGE(PG8_SA(0, 1), a2 + hstep, voffA);
            PG8_WAIT_V(8); PG8_WAIT_L(0); PG8_BAR; PG8_MMA(0, 0, At, B0); PG8_MMA(0, 1, At, B1); PG8_BAR; PG8_SCHED;
            PG8_LDA(At, 1, 1); PG8_STAGE(PG8_SB(1, 0), b3, voffB); PG8_STAGE(PG8_SB(1, 1), b3 + hstep, voffB); PG8_STAGE(PG8_SA(1, 0), a3, voffA);
            PG8_WAIT_V(8); PG8_WAIT_L(0); PG8_BAR; PG8_MMA(1, 0, At, B0); PG8_MMA(1, 1, At, B1); PG8_BAR; PG8_SCHED;
        }
        if (wr == 0) PG8_BAR;
        E(acc, cur, wr, wc, fr, fq);
        if (!has_next) break;
#pragma unroll
        for (int a = 0; a < 2; ++a)
#pragma unroll
            for (int b = 0; b < 2; ++b)
#pragma unroll
                for (int m = 0; m < 4; ++m)
#pragma unroll
                    for (int n = 0; n < 2; ++n) acc[a][b][m][n] = (f32x4){0.f, 0.f, 0.f, 0.f};
        cur = nxt; cA = nA; cB = nB; ++ui;
        if (wr == 1) PG8_BAR;
    }
    PG8_WAIT_V(0);
    PG8_BAR;
#undef PG8_SA
#undef PG8_SB
#undef PG8_STAGE
#undef PG8_LDA
#undef PG8_LDB
#undef PG8_MMA
#undef PG8_WAIT_V
#undef PG8_WAIT_L
#undef PG8_BAR
#undef PG8_SCHED
}

struct EpiZ {
    static constexpr bool PERM = true;
    bf16_t* Z; float* GATE;
    DI void operator()(const f32x4 (&acc)[2][2][4][2], const Unit& u, int wr, int wc, int fr, int fq) const {
        const int row0 = u.pm * BM + wr * 64 + fr, col0 = u.pn * BM + wc * 32 + 8 * fq;
#pragma unroll
        for (int ai = 0; ai < 2; ++ai)
#pragma unroll
            for (int m = 0; m < 4; ++m) { const size_t row = (size_t)(row0 + ai * HALF + m * 16);
#pragma unroll
                for (int bj = 0; bj < 2; ++bj) { const int col = col0 + bj * HALF; const f32x4 v0 = acc[ai][bj][m][0], v1 = acc[ai][bj][m][1];
                    u32x4 w; w.x = pk2(v0[0], v0[1]); w.y = pk2(v0[2], v0[3]); w.z = pk2(v1[0], v1[1]); w.w = pk2(v1[2], v1[3]);
                    *(u32x4*)(Z + row * ZW + col) = w;
                    int gc = -1; if (col >= C_GC && col < C_GC + 32) gc = col - C_GC; else if (col >= C_ID && col < C_ID + 16) gc = 32 + col - C_ID;
                    if (gc >= 0) { float* gp = GATE + row * 48 + gc; *(f32x4*)gp = v0; *(f32x4*)(gp + 4) = v1; } } }
    }
};
struct EpiRelu2 {
    static constexpr bool PERM = true;
    bf16_t* U;
    DI void operator()(const f32x4 (&acc)[2][2][4][2], const Unit& u, int wr, int wc, int fr, int fq) const {
        const int row0 = u.pm * BM + wr * 64 + fr, col0 = u.pn * BM + wc * 32 + 8 * fq;
#pragma unroll
        for (int ai = 0; ai < 2; ++ai)
#pragma unroll
            for (int m = 0; m < 4; ++m) { const size_t row = (size_t)(row0 + ai * HALF + m * 16);
#pragma unroll
                for (int bj = 0; bj < 2; ++bj) { const int col = col0 + bj * HALF; f32x4 v0 = acc[ai][bj][m][0], v1 = acc[ai][bj][m][1];
#pragma unroll
                    for (int j = 0; j < 4; ++j) { const float a = fmaxf(v0[j], 0.f), b = fmaxf(v1[j], 0.f); v0[j] = a * a; v1[j] = b * b; }
                    u32x4 w; w.x = pk2(v0[0], v0[1]); w.y = pk2(v0[2], v0[3]); w.z = pk2(v1[0], v1[1]); w.w = pk2(v1[2], v1[3]);
                    *(u32x4*)(U + row * FF + col) = w; } }
    }
};
struct EpiRes {
    static constexpr bool PERM = true;
    Params P; int from_input; const float* ga;
    DI void operator()(const f32x4 (&acc)[2][2][4][2], const Unit& u, int wr, int wc, int fr, int fq) const {
        const int b = u.pm / 17, tl = u.pm % 17;
        const float* rbase = from_input ? xin_tile(P, b, tl) : xst_tile(P, b, tl);
        float* dbase = xst_tile(P, b, tl);
        const float* garow = ga + (size_t)(tl == 0 ? 8 : b) * 6144;
        const int rin = wr * 64 + fr, col0 = u.pn * BM + wc * 32 + 8 * fq;
#pragma unroll
        for (int bj = 0; bj < 2; ++bj) { const int col = col0 + bj * HALF; const f32x4 g0 = *(const f32x4*)(garow + col), g1 = *(const f32x4*)(garow + col + 4);
#pragma unroll
            for (int ai = 0; ai < 2; ++ai)
#pragma unroll
                for (int m = 0; m < 4; ++m) { const size_t off = (size_t)(rin + ai * HALF + m * 16) * D + col;
                    if (u.split) { float* sp = (float*)(P.ws + WS_SLAB) + ((size_t)u.sl * (NB * CTX) + (size_t)b * CTX) * D + off;
                        *(f32x4*)sp = g0 * acc[ai][bj][m][0]; *(f32x4*)(sp + 4) = g1 * acc[ai][bj][m][1]; }
                    else { const f32x4 x0 = *(const f32x4*)(rbase + off), x1 = *(const f32x4*)(rbase + off + 4);
                        *(f32x4*)(dbase + off) = x0 + g0 * acc[ai][bj][m][0]; *(f32x4*)(dbase + off + 4) = x1 + g1 * acc[ai][bj][m][1]; } } }
    }
};
}

DI void transpose_item(const int wv, const float* W, int K, int N, bf16_t* WT, int kb, int nb, LAS float* tile) {
    const int tid = otid(wv), k0 = kb * 64, n0 = nb * 256;
    { const int kk = tid >> 4, c4 = (tid & 15) * 4; f32x4 v[2][4];
#pragma unroll
      for (int i = 0; i < 2; ++i)
#pragma unroll
          for (int j = 0; j < 4; ++j) { const int n = n0 + c4 + 64 * j; v[i][j] = (f32x4){0.f, 0.f, 0.f, 0.f}; if (n < N) v[i][j] = *(const f32x4*)(W + (size_t)(k0 + kk + 32 * i) * N + n); }
#pragma unroll
      for (int i = 0; i < 2; ++i)
#pragma unroll
          for (int j = 0; j < 4; ++j) { LAS float* tp = tile + (kk + 32 * i) * 257 + c4 + 64 * j; tp[0] = v[i][j][0]; tp[1] = v[i][j][1]; tp[2] = v[i][j][2]; tp[3] = v[i][j][3]; } }
    __syncthreads();
    { const int kc = (tid & 7) * 8;
#pragma unroll
      for (int j = 0; j < 4; ++j) { const int n = (tid >> 3) + 64 * j; const LAS float* s = tile + kc * 257 + n;
          u32x4 o; o.x = pk2(s[0], s[257]); o.y = pk2(s[2 * 257], s[3 * 257]); o.z = pk2(s[4 * 257], s[5 * 257]); o.w = pk2(s[6 * 257], s[7 * 257]);
          *(u32x4*)(WT + (size_t)(n0 + n) * K + k0 + kc) = o; } }
    __syncthreads();
}
DI void mod_item(const KP& P, int l, int nc, LAS float* S  , LAS float* red  ) {
    const int tid = otid(P.wv);
    for (int idx = tid; idx < 9 * D; idx += 512) { const int r = idx >> 10, k = idx & 1023; const float v = r < 8 ? P.c[r * D + k] : P.c_ctx[k]; S[idx] = v / (1.f + expf(-v)); }
    __syncthreads();
    const int col = tid % 48, kq = tid / 48, n0 = nc * 48;
    if (kq < 8) {
        float a[9];
#pragma unroll
        for (int r = 0; r < 9; ++r) a[r] = 0.f;
        const float* w = P.w_mod + (size_t)l * D * 6144 + n0 + col;
#pragma unroll 4
        for (int k = kq * 128; k < kq * 128 + 128; ++k) { const float wv = w[(size_t)k * 6144];
#pragma unroll
            for (int r = 0; r < 9; ++r) a[r] += S[r * D + k] * wv; }
#pragma unroll
        for (int r = 0; r < 9; ++r) red[(kq * 9 + r) * 48 + col] = a[r];
    }
    __syncthreads();
    float* MOD = (float*)(P.ws + WS_MOD);
    if (tid < 9 * 48) { const int r = tid / 48, cc = tid % 48; float s = P.b_mod[l * 6144 + n0 + cc];
#pragma unroll
        for (int q = 0; q < 8; ++q) s += red[(q * 9 + r) * 48 + cc];
        MOD[((size_t)l * 9 + r) * 6144 + n0 + cc] = s; }
    __syncthreads();
}
DI void p0_phase(const KP& P, LAS unsigned char* lds, const int lsel  ) {
    const int G = gridDim.x;
    LAS float* lf = (LAS float*)lds;
    if (lsel == 0) for (int it = blockIdx.x; it < 256; it += G) mod_item(P, it >> 7, it & 127, lf, lf + 9 * D);
    if (lsel == 0) { float* XC = (float*)(P.ws + WS_XC); const int gt = blockIdx.x * 512 + otid(P.wv);
      for (int i = gt; i < NB * CTX * D / 4; i += G * 512) ((f32x4*)XC)[i] = ((const f32x4*)P.ctx)[i]; }
    constexpr int I_IN = 16 * 12, I_OUT = 16 * 4, I_1 = 16 * 16, I_2 = 64 * 4, PER = I_IN + I_OUT + I_1 + I_2;
    for (int it = rot((int)blockIdx.x, 160, G); it < PER; it += G) {
        const int l = lsel; int r = it;
        if (r < I_IN) { transpose_item(P.wv, P.w_in + (size_t)l * D * INW, D, INW, (bf16_t*)(P.ws + WS_WIN) + (size_t)l * ZW * D, r / 12, r % 12, lf); continue; } r -= I_IN;
        if (r < I_OUT) { transpose_item(P.wv, P.w_out + (size_t)l * D * D, D, D, (bf16_t*)(P.ws + WS_WOUT) + (size_t)l * D * D, r / 4, r % 4, lf); continue; } r -= I_OUT;
        if (r < I_1) { transpose_item(P.wv, P.w_mlp1 + (size_t)l * D * FF, D, FF, (bf16_t*)(P.ws + WS_W1) + (size_t)l * FF * D, r / 16, r % 16, lf); continue; } r -= I_1;
        transpose_item(P.wv, P.w_mlp2 + (size_t)l * FF * D, FF, D, (bf16_t*)(P.ws + WS_W2) + (size_t)l * D * FF, r / 4, r % 4, lf);
    }
}

DI void norm_phase(const KP& P, int layer, int which  , int skip_ctx) {
    const int tid = otid(P.wv), lane = tid & 63, wave = tid >> 6;
    const int gw = blockIdx.x * 8 + wave, NGW = gridDim.x * 8;
    const float* MOD = (const float*)(P.ws + WS_MOD);
    bf16_t* H = (bf16_t*)(P.ws + WS_H);
    const float* g = (which == 1 ? P.g_norm1 : P.g_norm2) + layer * D;
    const int nslab = (layer == 0 && which == 2) ? 4 : (layer == 1 && which == 1) ? 8 : 0;
    for (int R = gw; R < MROWS; R += NGW) {
        const int b = R / TT, t = R % TT;
        if (skip_ctx && t < CTX) continue;
        const int tl = t < CTX ? 0 : 1 + ((t - CTX) >> 8), rin = t < CTX ? t : ((t - CTX) & 255);
        const float* src = ((which == 1 && layer == 0) ? xin_tile(P, b, tl) : xst_tile(P, b, tl)) + (size_t)rin * D;
        const float* mrow = MOD + ((size_t)layer * 9 + (t < CTX ? 8 : b)) * 6144 + (which == 1 ? 0 : 3072);
        f32x4 v[4]; float ss = 0.f;
#pragma unroll
        for (int j = 0; j < 4; ++j) v[j] = *(const f32x4*)(src + 8 * lane + 512 * (j >> 1) + 4 * (j & 1));
        if (nslab && t < CTX) { const float* sl = (const float*)(P.ws + WS_SLAB) + ((size_t)b * CTX + t) * D + 8 * lane;
            for (int s = 0; s < nslab; ++s)
#pragma unroll
                for (int j = 0; j < 4; ++j) v[j] = v[j] + *(const f32x4*)(sl + (size_t)s * (NB * CTX) * D + 512 * (j >> 1) + 4 * (j & 1));
            if (which == 2) { float* dst = xst_tile(P, b, 0) + (size_t)rin * D + 8 * lane;
#pragma unroll
                for (int j = 0; j < 4; ++j) *(f32x4*)(dst + 512 * (j >> 1) + 4 * (j & 1)) = v[j]; } }
#pragma unroll
        for (int j = 0; j < 4; ++j) { ss += v[j][0] * v[j][0] + v[j][1] * v[j][1] + v[j][2] * v[j][2] + v[j][3] * v[j][3]; }
#pragma unroll
        for (int o = 1; o < 64; o <<= 1) ss += __shfl_xor(ss, o);
        const float rstd = rsqrtf(ss * (1.f / D) + EPS);
#pragma unroll
        for (int jj = 0; jj < 2; ++jj) { u32x4 o;
#pragma unroll
            for (int hh = 0; hh < 2; ++hh) { const int j = 2 * jj + hh, col = 8 * lane + 512 * jj + 4 * hh;
                const f32x4 gg = *(const f32x4*)(g + col), sh = *(const f32x4*)(mrow + col), sc = *(const f32x4*)(mrow + 1024 + col);
                f32x4 y;
#pragma unroll
                for (int e = 0; e < 4; ++e) y[e] = v[j][e] * rstd * gg[e] * (1.f + sc[e]) + sh[e];
                if (hh == 0) { o.x = pk2(y[0], y[1]); o.y = pk2(y[2], y[3]); } else { o.z = pk2(y[0], y[1]); o.w = pk2(y[2], y[3]); } }
            *(u32x4*)(H + (size_t)R * D + 8 * lane + 512 * jj) = o; }
    }
}

DI void attn_prep_item(const KP& P, int layer, int b, int tb, LAS unsigned char* lds) {
    const int tid = otid(P.wv), lane = tid & 63, wave = tid >> 6;
    bf16_t* Z = (bf16_t*)(P.ws + WS_Z);
    const int t0 = tb * 64; const size_t R0 = (size_t)b * TT + t0;
    { const int p = lane & 31, hv = lane >> 5, fi = p & 15;
      const float inv = exp2f(-(float)fi * (13.287712379549449f / 16.f));
      float gk_a[2], gk_b[2];
#pragma unroll
      for (int e = 0; e < 2; ++e) { gk_a[e] = P.g_k_a[layer * 64 + 2 * p + e]; gk_b[e] = P.g_k_b[layer * 64 + 2 * p + e]; }
      unsigned uu[8][2];
#pragma unroll
      for (int ti = 0; ti < 8; ++ti)
#pragma unroll
          for (int i = 0; i < 2; ++i) { const int cb = (i ? C_KB : C_KA) + 64 * hv; uu[ti][i] = *(const unsigned*)(Z + (R0 + wave * 8 + ti) * ZW + cb + 2 * p); }
#pragma unroll
      for (int ti = 0; ti < 8; ++ti) { const int t = t0 + wave * 8 + ti; bf16_t* zr = Z + (R0 + wave * 8 + ti) * ZW;
          float cs = 1.f, sn = 0.f;
          if (t >= CTX) { const int tl = t - CTX; const float pos = (float)(p < 16 ? (tl >> 6) : (tl & 63)); const float ang = pos * inv; cs = __cosf(ang); sn = __sinf(ang); }
#pragma unroll
          for (int i = 0; i < 2; ++i) { const int cb = (i ? C_KB : C_KA) + 64 * hv;
              const float g0 = i ? gk_b[0] : gk_a[0], g1 = i ? gk_b[1] : gk_a[1];
              const unsigned u = uu[ti][i]; const float x1 = bflo(u), x2 = bfhi(u);
              float ss = x1 * x1 + x2 * x2;
#pragma unroll
              for (int o = 1; o < 32; o <<= 1) ss += __shfl_xor(ss, o);
              const float rstd = rsqrtf(ss * (1.f / 64.f) + EPS);
              const float y1 = x1 * rstd * g0, y2 = x2 * rstd * g1;
              *(unsigned*)(zr + cb + 2 * p) = pk2(y1 * cs - y2 * sn, y1 * sn + y2 * cs); } } }
}

DI void gla_prep_item(const KP& P, int layer, int b, int tb, LAS unsigned char* lds) {
    const int tid = otid(P.wv), lane = tid & 63, wave = tid >> 6, r = lane & 31, h = lane >> 5;
    const bf16_t* Z = (const bf16_t*)(P.ws + WS_Z); const float* GATE = (const float*)(P.ws + WS_GATE);
    const int t0 = tb * 64; const size_t R0 = (size_t)b * TT + t0;
    constexpr int KP_ = 144, VP = 272;
    LAS bf16_t* Kt = (LAS bf16_t*)lds;
    LAS bf16_t* Vt = (LAS bf16_t*)(lds + 18432);
    LAS float* Bc = (LAS float*)(lds + 53248);
    LAS float* Gt = (LAS float*)(lds + 118784);
    { u32x4 kv[2], vv[4];
#pragma unroll
      for (int i = 0; i < 2; ++i) { const int q = tid + 512 * i, row = q >> 4, ch = q & 15; kv[i] = ldg16(Z + (R0 + row) * ZW + C_KC + ch * 8); }
#pragma unroll
      for (int i = 0; i < 4; ++i) { const int q = tid + 512 * i, row = q >> 5, ch = q & 31; vv[i] = ldg16(Z + (R0 + row) * ZW + C_VC + ch * 8); }
      const int tok = tid >> 3, c4 = (tid & 7) * 4; const f32x4 gv = *(const f32x4*)(GATE + (R0 + tok) * 48 + c4);
#pragma unroll
      for (int i = 0; i < 2; ++i) { const int q = tid + 512 * i, row = q >> 4, ch = q & 15; *(LAS u32x4*)(Kt + row * KP_ + ch * 8) = kv[i]; }
#pragma unroll
      for (int i = 0; i < 4; ++i) { const int q = tid + 512 * i, row = q >> 5, ch = q & 31; *(LAS u32x4*)(Vt + row * VP + ch * 8) = vv[i]; }
      *(LAS f32x4*)(Gt + tok * 32 + c4) = gv; }
    __syncthreads();
    float* BG = (float*)(P.ws + WS_BG);
    { const int dc = tid & 255, dir = dc >> 7, ch = dc & 127;
      float w[16];
#pragma unroll
      for (int k = 0; k < 16; ++k) w[k] = P.w_gla_gate[(((size_t)layer * 2 + dir) * 16 + k) * 128 + ch];
      const float bias = P.b_gla_gate[(layer * 2 + dir) * 128 + ch];
      for (int i = 0; i < 32; ++i) { const int t = (tid >> 8) + 2 * i; float pre = bias;
#pragma unroll
          for (int k = 0; k < 16; ++k) pre += Gt[t * 32 + dir * 16 + k] * w[k];
          Bc[(dir * 64 + t) * 128 + ch] = logsig(pre) * (1.f / 16.f); } }
    __syncthreads();
    if (tid < 256) { const int dir = tid >> 7, ch = tid & 127; float run = 0.f;
        for (int step = 0; step < 64; ++step) { const int t = dir ? 63 - step : step;
            run += Bc[(dir * 64 + t) * 128 + ch]; Bc[(dir * 64 + t) * 128 + ch] = run; BG[(R0 + t) * 256 + dir * 128 + ch] = run; } }
    __syncthreads();
    { const int hd = wave & 3, dir = wave >> 2;
      const float be = Bc[(dir * 64 + (dir ? 0 : 63)) * 128 + hd * 32 + r];
      const int qq = (lane & 15) >> 2, pp = lane & 3, blk = (lane >> 4) & 1;
      const int vtrK = (8 * h + qq) * KP_ + 16 * blk + 4 * pp + hd * 32, vtrV = (8 * h + qq) * VP + 16 * blk + 4 * pp + hd * 64;
      f32x16 acc[2]; acc[0] = zero16(); acc[1] = zero16();
#pragma unroll
      for (int kk = 0; kk < 4; ++kk) { const int s0 = 16 * kk + 8 * h;
          const s16x4 klo = trr(Kt + vtrK + 16 * kk * KP_), khi = trr(Kt + vtrK + (16 * kk + 4) * KP_);
          float kw[8];
#pragma unroll
          for (int j = 0; j < 4; ++j) { kw[j] = bf2f((bf16_t)klo[j]) * __expf(be - Bc[(dir * 64 + s0 + j) * 128 + hd * 32 + r]); kw[4 + j] = bf2f((bf16_t)khi[j]) * __expf(be - Bc[(dir * 64 + s0 + 4 + j) * 128 + hd * 32 + r]); }
          u32x4 bp; bp.x = pk2(kw[0], kw[1]); bp.y = pk2(kw[2], kw[3]); bp.z = pk2(kw[4], kw[5]); bp.w = pk2(kw[6], kw[7]);
#pragma unroll
          for (int mt = 0; mt < 2; ++mt) { const LAS bf16_t* vp = Vt + vtrV + 16 * kk * VP + 32 * mt; acc[mt] = MFMA32(cat4(trr(vp), trr(vp + 4 * VP)), as_bf8(bp), acc[mt]); } }
      const int chain = (b * 2 + dir) * 4 + hd, c = dir ? (tb < 4 ? 3 - tb : 71 - tb) : tb;
      bf16_t* UG = (bf16_t*)(P.ws + WS_UGC) + ((size_t)chain * NTB + c) * 2048;
#pragma unroll
      for (int mt = 0; mt < 2; ++mt)
#pragma unroll
          for (int i = 0; i < 16; ++i) UG[(32 * mt + crow(i, h)) * 32 + r] = f2bf(acc[mt][i]);
      if (h == 0) ((float*)(P.ws + WS_DGC))[((size_t)chain * NTB + c) * 32 + r] = __expf(be); }
    __syncthreads();
}

DI void mlstm_prep_item(const KP& P, int layer, int b, int tb, LAS unsigned char* lds) {
    const int tid = otid(P.wv), lane = tid & 63, wave = tid >> 6, r = lane & 31, h = lane >> 5;
    const bf16_t* Z = (const bf16_t*)(P.ws + WS_Z); const float* GATE = (const float*)(P.ws + WS_GATE);
    const int t0 = tb * 64; const size_t R0 = (size_t)b * TT + t0;
    constexpr int VP = 272;
    LAS bf16_t* Kt = (LAS bf16_t*)lds;
    LAS bf16_t* Vt = (LAS bf16_t*)(lds + 34816);
    LAS float* Fl = (LAS float*)(lds + 69632);
    LAS float* Il = Fl + 512;
    LAS float* Gt = Il + 512;
    { u32x4 kv[4], vv[4];
#pragma unroll
      for (int i = 0; i < 4; ++i) { const int q = tid + 512 * i, row = q >> 5, ch = q & 31; const bf16_t* zr = Z + (R0 + row) * ZW + ch * 8; kv[i] = ldg16(zr + C_KD); vv[i] = ldg16(zr + C_VD); }
      f32x4 gv = {0.f, 0.f, 0.f, 0.f};
      if (tid < 256) { const int tok = tid >> 2, c4 = (tid & 3) * 4; gv = *(const f32x4*)(GATE + (R0 + tok) * 48 + 32 + c4); }
#pragma unroll
      for (int i = 0; i < 4; ++i) { const int q = tid + 512 * i, row = q >> 5, ch = q & 31; *(LAS u32x4*)(Kt + row * VP + ch * 8) = kv[i]; *(LAS u32x4*)(Vt + row * VP + ch * 8) = vv[i]; }
      if (tid < 256) { const int tok = tid >> 2, c4 = (tid & 3) * 4; *(LAS f32x4*)(Gt + tok * 16 + c4) = gv; } }
    __syncthreads();
    { const int t = tid >> 3, gi = tid & 7;
      Il[gi * 64 + t] = Gt[t * 16 + gi] + P.b_mlstm_i[layer * 8 + gi]; Fl[gi * 64 + t] = logsig(Gt[t * 16 + 8 + gi] + P.b_mlstm_f[layer * 8 + gi]); }
    __syncthreads();
    if (tid < 8) { const int dir = tid >> 2;
        float* FG = (float*)(P.ws + WS_FG); float* IG = (float*)(P.ws + WS_IG);
        float run = 0.f;
        for (int step = 0; step < 64; ++step) { const int t = dir ? 63 - step : step;
            run += Fl[tid * 64 + t]; Fl[tid * 64 + t] = run; FG[(R0 + t) * 8 + tid] = run; IG[(R0 + t) * 8 + tid] = Il[tid * 64 + t] - run; } }
    __syncthreads();
    { const int hd = wave & 3, dir = wave >> 2, gi = dir * 4 + hd;
      const float Fend = Fl[gi * 64 + (dir ? 0 : 63)];
      const int vtr = (8 * h + ((lane & 15) >> 2)) * VP + 16 * ((lane >> 4) & 1) + 4 * (lane & 3) + hd * 64;
      f32x16 acc[2][2]; acc[0][0] = zero16(); acc[0][1] = zero16(); acc[1][0] = zero16(); acc[1][1] = zero16();
      float nsum[2] = {0.f, 0.f};
#pragma unroll
      for (int kk = 0; kk < 4; ++kk) { const int s0 = 16 * kk + 8 * h;
          float wts[8];
#pragma unroll
          for (int j = 0; j < 8; ++j) wts[j] = __expf(Fend - Fl[gi * 64 + s0 + j] + Il[gi * 64 + s0 + j]) * 0.125f;
          u32x4 bp[2];
#pragma unroll
          for (int nt = 0; nt < 2; ++nt) { const LAS bf16_t* kp = Kt + vtr + 16 * kk * VP + 32 * nt; const s16x4 klo = trr(kp), khi = trr(kp + 4 * VP);
              float kw[8];
#pragma unroll
              for (int j = 0; j < 4; ++j) { kw[j] = bf2f((bf16_t)klo[j]) * wts[j]; kw[4 + j] = bf2f((bf16_t)khi[j]) * wts[4 + j]; nsum[nt] += kw[j] + kw[4 + j]; }
              bp[nt].x = pk2(kw[0], kw[1]); bp[nt].y = pk2(kw[2], kw[3]); bp[nt].z = pk2(kw[4], kw[5]); bp[nt].w = pk2(kw[6], kw[7]); }
#pragma unroll
          for (int mt = 0; mt < 2; ++mt) { const LAS bf16_t* vp = Vt + vtr + 16 * kk * VP + 32 * mt; const bf16x8 av = cat4(trr(vp), trr(vp + 4 * VP));
#pragma unroll
              for (int nt = 0; nt < 2; ++nt) acc[mt][nt] = MFMA32(av, as_bf8(bp[nt]), acc[mt][nt]); } }
      const int chain = (b * 2 + dir) * 4 + hd, c = dir ? (tb < 4 ? 3 - tb : 71 - tb) : tb;
      bf16_t* UG = (bf16_t*)(P.ws + WS_UGD) + ((size_t)chain * NTB + c) * 4096;
#pragma unroll
      for (int mt = 0; mt < 2; ++mt)
#pragma unroll
          for (int nt = 0; nt < 2; ++nt)
#pragma unroll
              for (int i = 0; i < 16; ++i) UG[(32 * mt + crow(i, h)) * 64 + 32 * nt + r] = f2bf(acc[mt][nt][i]);
#pragma unroll
      for (int nt = 0; nt < 2; ++nt) { nsum[nt] += __shfl_xor(nsum[nt], 32); if (h == 0) ((float*)(P.ws + WS_NGD))[((size_t)chain * NTB + c) * 64 + 32 * nt + r] = nsum[nt]; }
      if (lane == 0) ((float*)(P.ws + WS_DGD))[(size_t)chain * NTB + c] = __expf(Fend); }
    __syncthreads();
}

DI void prep_phase(const KP& P, int layer, LAS unsigned char* lds) {
    const int G = gridDim.x; constexpr int NBT = NB * NTB;
    for (int it = blockIdx.x; it < NBT; it += G) mlstm_prep_item(P, layer, it / NTB, it % NTB, lds);
    for (int it = rot((int)blockIdx.x, 224, G); it < NBT; it += G) gla_prep_item(P, layer, it / NTB, it % NTB, lds);
    for (int it = rot((int)blockIdx.x, 192, G); it < NBT; it += G) attn_prep_item(P, layer, it / NTB, it % NTB, lds);
}

DI void chain_phase(const KP& P) {
    const int gt = blockIdx.x * 512 + otid(P.wv), GS = gridDim.x * 512;
    bf16_t* UC = (bf16_t*)(P.ws + WS_UGC); const float* DC = (const float*)(P.ws + WS_DGC);
    bf16_t* UD = (bf16_t*)(P.ws + WS_UGD); const float* DD = (const float*)(P.ws + WS_DGD); float* NG = (float*)(P.ws + WS_NGD);
    for (int e = gt; e < 64 * 2048; e += GS) { const int chain = e >> 11, idx = e & 2047, d = idx & 31; float s = 0.f;
#pragma unroll 1
        for (int c0 = 0; c0 < NTB; c0 += 17) { float u[17], dc[17];
#pragma unroll
            for (int j = 0; j < 17; ++j) { const size_t p = (size_t)chain * NTB + c0 + j; u[j] = bf2f(UC[p * 2048 + idx]); dc[j] = DC[p * 32 + d]; }
#pragma unroll
            for (int j = 0; j < 17; ++j) { const size_t p = (size_t)chain * NTB + c0 + j; UC[p * 2048 + idx] = f2bf(s); s = dc[j] * s + u[j]; } } }
    for (int e = gt; e < 64 * 4096; e += GS) { const int chain = e >> 12, idx = e & 4095; float s = 0.f;
#pragma unroll 1
        for (int c0 = 0; c0 < NTB; c0 += 17) { float u[17], dc[17];
#pragma unroll
            for (int j = 0; j < 17; ++j) { const size_t p = (size_t)chain * NTB + c0 + j; u[j] = bf2f(UD[p * 4096 + idx]); dc[j] = DD[p]; }
#pragma unroll
            for (int j = 0; j < 17; ++j) { const size_t p = (size_t)chain * NTB + c0 + j; UD[p * 4096 + idx] = f2bf(s); s = dc[j] * s + u[j]; } } }
    for (int e = gt; e < 64 * 64; e += GS) { const int chain = e >> 6, idx = e & 63; float s = 0.f;
#pragma unroll 1
        for (int c0 = 0; c0 < NTB; c0 += 17) { float u[17], dc[17];
#pragma unroll
            for (int j = 0; j < 17; ++j) { const size_t p = (size_t)chain * NTB + c0 + j; u[j] = NG[p * 64 + idx]; dc[j] = DD[p]; }
#pragma unroll
            for (int j = 0; j < 17; ++j) { const size_t p = (size_t)chain * NTB + c0 + j; NG[p * 64 + idx] = s; s = dc[j] * s + u[j]; } } }
}

DI void attn_item(const KP& P, int layer, int mix  , int b, int g, int q0  , int lo, int hi, int window, LAS unsigned char* lds) {
    const int tid = otid(P.wv), lane = tid & 63, wave = tid >> 6, r = lane & 31, h = lane >> 5;
    const bf16_t* Z = (const bf16_t*)(P.ws + WS_Z); bf16_t* O = (bf16_t*)(P.ws + WS_O);
    const int head = g * 2 + (wave >> 2), tq = q0 + 32 * (wave & 3) + r;
    const int qcol = mix ? C_QB : C_QA, kcol = (mix ? C_KB : C_KA) + g * 64;
    const size_t Rb = (size_t)b * TT;
    LAS bf16_t* Kt = (LAS bf16_t*)lds;
    LAS bf16_t* Vt = (LAS bf16_t*)(lds + 18432);
    constexpr int KB_ = 64 * 72, VB_ = 64 * 72;
    const int vtr = (4 * h + ((lane & 15) >> 2)) * 72 + 16 * ((lane >> 4) & 1) + 4 * (lane & 3);
    bf16x8 Qf[4];
    const float QS = 0.18033688011112042f;
    { u32x4 qr[4]; float ss = 0.f;
#pragma unroll
      for (int kk = 0; kk < 4; ++kk) { qr[kk] = ldg16(Z + (Rb + tq) * ZW + qcol + head * 64 + 16 * kk + 8 * h);
#pragma unroll
          for (int j = 0; j < 4; ++j) { const float x1 = bflo(qr[kk][j]), x2 = bfhi(qr[kk][j]); ss += x1 * x1 + x2 * x2; } }
      ss += __shfl_xor(ss, 32);
      const float rstd = rsqrtf(ss * (1.f / 64.f) + EPS);
      const float* gq = (mix ? P.g_q_b : P.g_q_a) + layer * 64;
      const bool rope = tq >= CTX; const int tl = tq - CTX; const float prow = (float)(tl >> 6), pcol = (float)(tl & 63);
#pragma unroll
      for (int kk = 0; kk < 4; ++kk) { const f32x4 g0 = *(const f32x4*)(gq + 16 * kk + 8 * h), g1 = *(const f32x4*)(gq + 16 * kk + 8 * h + 4);
          const float gg[8] = {g0[0], g0[1], g0[2], g0[3], g1[0], g1[1], g1[2], g1[3]};
          u32x4 o;
#pragma unroll
          for (int j = 0; j < 4; ++j) { const int fi = 8 * (kk & 1) + 4 * h + j;
              float cs = 1.f, sn = 0.f;
              if (rope) { const float ang = (kk < 2 ? prow : pcol) * exp2f(-(float)fi * (13.287712379549449f / 16.f)); cs = __cosf(ang); sn = __sinf(ang); }
              const float y1 = bflo(qr[kk][j]) * rstd * gg[2 * j] * QS, y2 = bfhi(qr[kk][j]) * rstd * gg[2 * j + 1] * QS;
              o[j] = pk2(y1 * cs - y2 * sn, y1 * sn + y2 * cs); }
          Qf[kk] = as_bf8(o); } }
    float m, l = 0.f;
    { float gq = fabsf(((mix ? P.g_q_b : P.g_q_a) + layer * 64)[lane]), gk = fabsf(((mix ? P.g_k_b : P.g_k_a) + layer * 64)[lane]);
#pragma unroll
      for (int o = 1; o < 64; o <<= 1) { gq = fmaxf(gq, __shfl_xor(gq, o)); gk = fmaxf(gk, __shfl_xor(gk, o)); }
      m = fminf(8.f * 1.02f * gq * gk * 1.4426950408889634f, 40.f); }
    if (mix) { const float sk = P.sink_b[layer * 4 + head] * 1.4426950408889634f; m = fmaxf(m, sk); l = h ? 0.f : __builtin_amdgcn_exp2f(sk - m); }
    f32x16 accO[2]; accO[0] = zero16(); accO[1] = zero16();
    f32x16 negm;
#pragma unroll
    for (int i = 0; i < 16; ++i) negm[i] = -m;
    const int ntiles = 4 + (hi - lo);
    const int srow = tid >> 3, sch = (tid & 7) * 8;
    const bf16_t* kbase = Z + (Rb + srow) * ZW + kcol + sch;
    const bf16_t* vbase = Z + (Rb + srow) * ZW + (mix ? C_VB : C_VA) + g * 64 + sch;
#define TILE_KEY(i) (((i) < 4 ? (i) : lo + (i) - 4) * 64)
#define LOADK(i, kr) do { if ((i) < ntiles) kr = ldg16(kbase + (size_t)TILE_KEY(i) * ZW); } while (0)
#define LOADV(i, vr) do { if ((i) < ntiles) vr = ldg16(vbase + (size_t)TILE_KEY(i) * ZW); } while (0)
#define STOREK(i, buf, kr) do { if ((i) < ntiles) *(LAS u32x4*)(Kt + (buf) * KB_ + srow * 72 + sch) = kr; } while (0)
#define STOREV(i, buf, vr) do { if ((i) < ntiles) *(LAS u32x4*)(Vt + (buf) * VB_ + srow * 72 + sch) = vr; } while (0)
#define QK(dst, buf) do { const LAS bf16_t* Kc = Kt + (buf) * KB_; \
        _Pragma("unroll") for (int jt = 0; jt < 2; ++jt) { dst[jt] = negm; \
            _Pragma("unroll") for (int kk = 0; kk < 4; ++kk) { const bf16x8 a = *(const LAS bf16x8*)(Kc + (32 * jt + r) * 72 + 16 * kk + 8 * h); dst[jt] = MFMA32(a, Qf[kk], dst[jt]); } } } while (0)
#define TILE_STEP(it_, p_, kLd, vLd, kSt, vSt) do { \
        const int it = (it_); \
        LOADK(it + 3, kLd); LOADV(it + 2, vLd); \
        f32x16 Sn[2]; \
        if (window && it >= 4) { const int ktile = lo + it - 4; \
            _Pragma("unroll") for (int jt = 0; jt < 2; ++jt) \
                _Pragma("unroll") for (int i = 0; i < 16; ++i) { const int kp = ktile * 64 + 32 * jt + crow(i, h); const int dlt = tq - kp; if (dlt > 128 || dlt < -128) S[jt][i] = -1e30f; } \
        } \
          \
        f32x2 ls2 = {0.f, 0.f}; \
        { const LAS bf16_t* Kn = Kt + ((p_) ^ 1) * KB_; bf16x8 kf[8]; \
          _Pragma("unroll") for (int g_ = 0; g_ < 8; ++g_) kf[g_] = *(const LAS bf16x8*)(Kn + (32 * (g_ & 1) + r) * 72 + 16 * (g_ >> 1) + 8 * h); \
          __builtin_amdgcn_sched_barrier(0); \
          _Pragma("unroll") for (int g_ = 0; g_ < 8; ++g_) { \
              Sn[g_ & 1] = MFMA32(kf[g_], Qf[g_ >> 1], g_ < 2 ? negm : Sn[g_ & 1]); \
              _Pragma("unroll") for (int e_ = 0; e_ < 4; e_ += 2) { const int jt = g_ >> 2, i = (g_ & 3) * 4 + e_; \
                  f32x2 t; t[0] = __builtin_amdgcn_exp2f(S[jt][i]); t[1] = __builtin_amdgcn_exp2f(S[jt][i + 1]); ls2 = ls2 + t; S[jt][i] = t[0]; S[jt][i + 1] = t[1]; } \
              __builtin_amdgcn_sched_barrier(0); } } \
        l += ls2[0] + ls2[1]; \
        { const LAS bf16_t* Vc = Vt + (p_) * VB_ + vtr; bf16x8 vf[8]; \
          _Pragma("unroll") for (int f_ = 0; f_ < 8; ++f_) { const LAS bf16_t* vp = Vc + (16 * (f_ >> 1)) * 72 + 32 * (f_ & 1); vf[f_] = cat4(trr(vp), trr(vp + 8 * 72)); }     \
          bf16x8 pf[4]; _Pragma("unroll") for (int f_ = 0; f_ < 4; ++f_) pf[f_] = pack8(S[f_ >> 1], f_ & 1); \
          __builtin_amdgcn_sched_barrier(0); \
          _Pragma("unroll") for (int f_ = 0; f_ < 8; ++f_) accO[f_ & 1] = MFMA32(vf[f_], pf[f_ >> 1], accO[f_ & 1]); } \
        S[0] = Sn[0]; S[1] = Sn[1]; \
        STOREK(it + 2, (p_), kSt); STOREV(it + 1, (p_) ^ 1, vSt); \
        __syncthreads(); } while (0)
    u32x4 kA = {0u, 0u, 0u, 0u}, vA = kA, kB = kA, vB = kA;
    f32x16 S[2];
    { u32x4 k0 = kA, k1 = kA, v0 = kA; LOADK(0, k0); LOADV(0, v0); LOADK(1, k1); LOADK(2, kA); LOADV(1, vA);
      STOREK(0, 0, k0); STOREV(0, 0, v0); STOREK(1, 1, k1); }
    __syncthreads();
    QK(S, 0);
    __syncthreads();
    for (int it2 = 0; it2 < ntiles; it2 += 2) {
        TILE_STEP(it2, 0, kB, vB, kA, vA);
        if (it2 + 1 < ntiles) TILE_STEP(it2 + 1, 1, kA, vA, kB, vB);
    }
#undef TILE_KEY
#undef LOADK
#undef LOADV
#undef STOREK
#undef STOREV
#undef QK
#undef TILE_STEP
    l += __shfl_xor(l, 32);
    const float il = 1.f / l;
    bf16_t* op = O + (Rb + tq) * D + (mix ? 256 : 0) + head * 64;
#pragma unroll
    for (int nt = 0; nt < 2; ++nt)
#pragma unroll
        for (int g4 = 0; g4 < 4; ++g4) { u32x2 o; o.x = pk2(accO[nt][4 * g4] * il, accO[nt][4 * g4 + 1] * il); o.y = pk2(accO[nt][4 * g4 + 2] * il, accO[nt][4 * g4 + 3] * il);
            *(u32x2*)(op + 32 * nt + 8 * g4 + 4 * h) = o; }
}

DI void gla_out_item(const KP& P, int layer, int b, int tb, LAS unsigned char* lds) {
    const int tid = otid(P.wv), lane = tid & 63, wave = tid >> 6, r = lane & 31, h = lane >> 5;
    const bf16_t* Z = (const bf16_t*)(P.ws + WS_Z); const float* BG = (const float*)(P.ws + WS_BG);
    const bf16_t* SG = (const bf16_t*)(P.ws + WS_UGC); bf16_t* O = (bf16_t*)(P.ws + WS_O);
    const int hd = wave & 3, mh = wave >> 2, t0 = tb * 64, t = 32 * mh + r; const size_t R0 = (size_t)b * TT + t0;
    constexpr int QP = 136, VP = 272, BP = 260;
    LAS bf16_t* Qt = (LAS bf16_t*)lds; LAS bf16_t* Kt = (LAS bf16_t*)(lds + 17408); LAS bf16_t* Vt = (LAS bf16_t*)(lds + 34816); LAS float* Bt = (LAS float*)(lds + 69632);
    { u32x4 qv[2], kv[2], vv[4]; f32x4 bv[8];
#pragma unroll
      for (int i = 0; i < 2; ++i) { const int q = tid + 512 * i, row = q >> 4, ch = q & 15; qv[i] = ldg16(Z + (R0 + row) * ZW + C_QC + ch * 8); kv[i] = ldg16(Z + (R0 + row) * ZW + C_KC + ch * 8); }
#pragma unroll
      for (int i = 0; i < 4; ++i) { const int q = tid + 512 * i, row = q >> 5, ch = q & 31; vv[i] = ldg16(Z + (R0 + row) * ZW + C_VC + ch * 8); }
#pragma unroll
      for (int i = 0; i < 8; ++i) { const int q = tid + 512 * i, row = q >> 6, ch = q & 63; bv[i] = *(const f32x4*)(BG + (R0 + row) * 256 + ch * 4); }
#pragma unroll
      for (int i = 0; i < 2; ++i) { const int q = tid + 512 * i, row = q >> 4, ch = q & 15; *(LAS u32x4*)(Qt + row * QP + ch * 8) = qv[i]; *(LAS u32x4*)(Kt + row * QP + ch * 8) = kv[i]; }
#pragma unroll
      for (int i = 0; i < 4; ++i) { const int q = tid + 512 * i, row = q >> 5, ch = q & 31; *(LAS u32x4*)(Vt + row * VP + ch * 8) = vv[i]; }
#pragma unroll
      for (int i = 0; i < 8; ++i) { const int q = tid + 512 * i, row = q >> 6, ch = q & 63; *(LAS f32x4*)(Bt + row * BP + ch * 4) = bv[i]; } }
    __syncthreads();
    const int vtr = (4 * h + ((lane & 15) >> 2)) * VP + 16 * ((lane >> 4) & 1) + 4 * (lane & 3) + hd * 64;
    f32x16 accO[2]; accO[0] = zero16(); accO[1] = zero16();
#pragma unroll 1
    for (int dir = 0; dir < 2; ++dir) {
        const int c = dir ? (tb < 4 ? 3 - tb : 71 - tb) : tb, chain = (b * 2 + dir) * 4 + hd;
        const bf16_t* sgp = SG + ((size_t)chain * NTB + c) * 2048 + (size_t)r * 32 + 8 * h;
        u32x4 Sf[2][2];
#pragma unroll
        for (int nt = 0; nt < 2; ++nt)
#pragma unroll
            for (int kk = 0; kk < 2; ++kk) Sf[nt][kk] = ldg16(sgp + nt * 1024 + 16 * kk);
        bf16x8 Qf[2];
#pragma unroll
        for (int kk = 0; kk < 2; ++kk) { const int d0 = hd * 32 + 16 * kk + 8 * h; const u32x4 qv = *(const LAS u32x4*)(Qt + t * QP + d0);
            const LAS float* bp = Bt + t * BP + dir * 128 + d0; const f32x4 b0 = *(const LAS f32x4*)bp, b1 = *(const LAS f32x4*)(bp + 4);
            const float sc = 0.17677669529663687f;
            u32x4 o; o.x = pk2(bflo(qv.x) * __expf(b0[0]) * sc, bfhi(qv.x) * __expf(b0[1]) * sc); o.y = pk2(bflo(qv.y) * __expf(b0[2]) * sc, bfhi(qv.y) * __expf(b0[3]) * sc);
            o.z = pk2(bflo(qv.z) * __expf(b1[0]) * sc, bfhi(qv.z) * __expf(b1[1]) * sc); o.w = pk2(bflo(qv.w) * __expf(b1[2]) * sc, bfhi(qv.w) * __expf(b1[3]) * sc);
            Qf[kk] = as_bf8(o); }
#pragma unroll
        for (int jt = 0; jt < 2; ++jt) { f32x16 S = zero16();
#pragma unroll
            for (int kk = 0; kk < 2; ++kk) { const int d0 = hd * 32 + 16 * kk + 8 * h; const u32x4 kv = *(const LAS u32x4*)(Kt + (32 * jt + r) * QP + d0);
                const LAS float* bp = Bt + (32 * jt + r) * BP + dir * 128 + d0; const f32x4 b0 = *(const LAS f32x4*)bp, b1 = *(const LAS f32x4*)(bp + 4);
                u32x4 o; o.x = pk2(bflo(kv.x) * __expf(-b0[0]), bfhi(kv.x) * __expf(-b0[1])); o.y = pk2(bflo(kv.y) * __expf(-b0[2]), bfhi(kv.y) * __expf(-b0[3]));
                o.z = pk2(bflo(kv.z) * __expf(-b1[0]), bfhi(kv.z) * __expf(-b1[1])); o.w = pk2(bflo(kv.w) * __expf(-b1[2]), bfhi(kv.w) * __expf(-b1[3]));
                S = MFMA32(as_bf8(o), Qf[kk], S); }
#pragma unroll
            for (int i = 0; i < 16; ++i) { const int s = 32 * jt + crow(i, h); const bool keep = dir ? (s >= t) : (s <= t); S[i] = keep ? S[i] : 0.f; }
            const bf16x8 Pf0 = pack8(S, 0), Pf1 = pack8(S, 1);
#pragma unroll
            for (int nt = 0; nt < 2; ++nt) { const LAS bf16_t* vp = Vt + vtr + (32 * jt) * VP + 32 * nt;
                accO[nt] = MFMA32(cat4(trr(vp), trr(vp + 8 * VP)), Pf0, accO[nt]);
                accO[nt] = MFMA32(cat4(trr(vp + 16 * VP), trr(vp + 24 * VP)), Pf1, accO[nt]); } }
#pragma unroll
        for (int nt = 0; nt < 2; ++nt)
#pragma unroll
            for (int kk = 0; kk < 2; ++kk) accO[nt] = MFMA32(as_bf8(Sf[nt][kk]), Qf[kk], accO[nt]);
    }
    float ss = 0.f;
#pragma unroll
    for (int nt = 0; nt < 2; ++nt)
#pragma unroll
        for (int i = 0; i < 16; ++i) ss += accO[nt][i] * accO[nt][i];
    ss += __shfl_xor(ss, 32);
    const float rstd = rsqrtf(ss * (1.f / 64.f) + EPS);
#pragma unroll
    for (int nt = 0; nt < 2; ++nt)
#pragma unroll
        for (int g4 = 0; g4 < 4; ++g4) { const int dv = 32 * nt + 8 * g4 + 4 * h;
            const u32x2 rv = ldg8(Z + (R0 + t) * ZW + C_RC + hd * 64 + dv); const f32x4 gg = *(const f32x4*)(P.g_gla_out + layer * 64 + dv);
            const float rr[4] = {bflo(rv.x), bfhi(rv.x), bflo(rv.y), bfhi(rv.y)}; float y[4];
#pragma unroll
            for (int e = 0; e < 4; ++e) { const float sl = rr[e] / (1.f + __expf(-rr[e])); y[e] = accO[nt][4 * g4 + e] * rstd * gg[e] * sl; }
            u32x2 o; o.x = pk2(y[0], y[1]); o.y = pk2(y[2], y[3]);
            *(u32x2*)(O + (R0 + t) * D + 512 + hd * 64 + dv) = o; }
    __syncthreads();
}

DI void mlstm_out_item(const KP& P, int layer, int b, int tb, LAS unsigned char* lds) {
    const int tid = otid(P.wv), lane = tid & 63, wave = tid >> 6, r = lane & 31, h = lane >> 5;
    const bf16_t* Z = (const bf16_t*)(P.ws + WS_Z); const float* FG = (const float*)(P.ws + WS_FG); const float* IG = (const float*)(P.ws + WS_IG);
    const bf16_t* SG = (const bf16_t*)(P.ws + WS_UGD); const float* NP = (const float*)(P.ws + WS_NGD); bf16_t* O = (bf16_t*)(P.ws + WS_O);
    const int hd = wave & 3, mh = wave >> 2, t0 = tb * 64, t = 32 * mh + r; const size_t R0 = (size_t)b * TT + t0;
    constexpr int QP = 264, VP = 272;
    LAS bf16_t* Qt = (LAS bf16_t*)lds; LAS bf16_t* Kt = (LAS bf16_t*)(lds + 33792); LAS bf16_t* Vt = (LAS bf16_t*)(lds + 67584);
    LAS float* Fs = (LAS float*)(lds + 102400); LAS float* As = Fs + 512;
    { u32x4 qv[4], kv[4], vv[4];
#pragma unroll
      for (int i = 0; i < 4; ++i) { const int q = tid + 512 * i, row = q >> 5, ch = q & 31; const bf16_t* zr = Z + (R0 + row) * ZW + ch * 8;
          qv[i] = ldg16(zr + C_QD); kv[i] = ldg16(zr + C_KD); vv[i] = ldg16(zr + C_VD); }
      f32x4 gv = {0.f, 0.f, 0.f, 0.f};
      if (tid < 128) gv = *(const f32x4*)(FG + R0 * 8 + tid * 4); else if (tid < 256) gv = *(const f32x4*)(IG + R0 * 8 + (tid - 128) * 4);
#pragma unroll
      for (int i = 0; i < 4; ++i) { const int q = tid + 512 * i, row = q >> 5, ch = q & 31;
          *(LAS u32x4*)(Qt + row * QP + ch * 8) = qv[i]; *(LAS u32x4*)(Kt + row * QP + ch * 8) = kv[i]; *(LAS u32x4*)(Vt + row * VP + ch * 8) = vv[i]; }
      if (tid < 256) *(LAS f32x4*)(Fs + tid * 4) = gv; }
    __syncthreads();
    bf16x8 Qf[4];
#pragma unroll
    for (int kk = 0; kk < 4; ++kk) Qf[kk] = *(const LAS bf16x8*)(Qt + t * QP + hd * 64 + 16 * kk + 8 * h);
    f32x16 S[2];
#pragma unroll
    for (int jt = 0; jt < 2; ++jt) { S[jt] = zero16();
#pragma unroll
        for (int kk = 0; kk < 4; ++kk) S[jt] = MFMA32(*(const LAS bf16x8*)(Kt + (32 * jt + r) * QP + hd * 64 + 16 * kk + 8 * h), Qf[kk], S[jt]); }
    const int vtr = (4 * h + ((lane & 15) >> 2)) * VP + 16 * ((lane >> 4) & 1) + 4 * (lane & 3) + hd * 64;
    f32x16 hs[2]; hs[0] = zero16(); hs[1] = zero16();
#pragma unroll 1
    for (int dir = 0; dir < 2; ++dir) {
        const int c = dir ? (tb < 4 ? 3 - tb : 71 - tb) : tb, chain = (b * 2 + dir) * 4 + hd, gi = dir * 4 + hd;
        const bf16_t* sgp = SG + ((size_t)chain * NTB + c) * 4096 + (size_t)r * 64 + 8 * h;
        f32x16 aI[2];
#pragma unroll
        for (int nt = 0; nt < 2; ++nt) { aI[nt] = zero16();
#pragma unroll
            for (int kk = 0; kk < 4; ++kk) aI[nt] = MFMA32(as_bf8(ldg16(sgp + nt * 2048 + 16 * kk)), Qf[kk], aI[nt]); }
        const float* np = NP + ((size_t)chain * NTB + c) * 64;
        float qn = 0.f;
#pragma unroll
        for (int kk = 0; kk < 4; ++kk) { const f32x4 n0 = *(const f32x4*)(np + 16 * kk + 8 * h), n1 = *(const f32x4*)(np + 16 * kk + 8 * h + 4); const u32x4 qv = __builtin_bit_cast(u32x4, Qf[kk]);
            qn += bflo(qv.x) * n0[0] + bfhi(qv.x) * n0[1] + bflo(qv.y) * n0[2] + bfhi(qv.y) * n0[3] + bflo(qv.z) * n1[0] + bfhi(qv.z) * n1[1] + bflo(qv.w) * n1[2] + bfhi(qv.w) * n1[3]; }
        qn += __shfl_xor(qn, 32);
        const float Ft = Fs[t * 8 + gi];
        float den = 0.f;
        f32x16 aP[2]; aP[0] = zero16(); aP[1] = zero16();
#pragma unroll
        for (int jt = 0; jt < 2; ++jt) { f32x16 Pv;
#pragma unroll
            for (int i = 0; i < 16; ++i) { const int s = 32 * jt + crow(i, h); const bool keep = dir ? (s >= t) : (s <= t);
                const float as = As[s * 8 + gi];
                const float pe = keep ? S[jt][i] * (__expf(Ft + as) * 0.125f) : 0.f; Pv[i] = pe; den += pe; }
            const bf16x8 Pf0 = pack8(Pv, 0), Pf1 = pack8(Pv, 1);
#pragma unroll
            for (int nt = 0; nt < 2; ++nt) { const LAS bf16_t* vp = Vt + vtr + (32 * jt) * VP + 32 * nt;
                aP[nt] = MFMA32(cat4(trr(vp), trr(vp + 8 * VP)), Pf0, aP[nt]);
                aP[nt] = MFMA32(cat4(trr(vp + 16 * VP), trr(vp + 24 * VP)), Pf1, aP[nt]); } }
        den += __shfl_xor(den, 32);
        const float ef = __expf(Ft), dtot = den + ef * qn, inv = 1.f / fmaxf(fabsf(dtot), 1.f);
#pragma unroll
        for (int nt = 0; nt < 2; ++nt) hs[nt] = hs[nt] + (aP[nt] + aI[nt] * ef) * inv;
    }
    float ss = 0.f;
#pragma unroll
    for (int nt = 0; nt < 2; ++nt)
#pragma unroll
        for (int i = 0; i < 16; ++i) ss += hs[nt][i] * hs[nt][i];
    ss += __shfl_xor(ss, 32);
    const float rstd = rsqrtf(ss * (1.f / 64.f) + EPS);
#pragma unroll
    for (int nt = 0; nt < 2; ++nt)
#pragma unroll
        for (int g4 = 0; g4 < 4; ++g4) { const int dv = 32 * nt + 8 * g4 + 4 * h;
            const u32x2 ov = ldg8(Z + (R0 + t) * ZW + C_OD + hd * 64 + dv); const f32x4 gg = *(const f32x4*)(P.g_mlstm_out + layer * 64 + dv);
            const float oo[4] = {bflo(ov.x), bfhi(ov.x), bflo(ov.y), bfhi(ov.y)}; float y[4];
#pragma unroll
            for (int e = 0; e < 4; ++e) { const float sg = 1.f / (1.f + __expf(-oo[e])); y[e] = hs[nt][4 * g4 + e] * rstd * gg[e] * sg; }
            u32x2 o; o.x = pk2(y[0], y[1]); o.y = pk2(y[2], y[3]);
            *(u32x2*)(O + (R0 + t) * D + 768 + hd * 64 + dv) = o; }
    __syncthreads();
}

DI void mixer_phase(const KP& P, int layer, LAS unsigned char* lds) {
    const int G = gridDim.x, bx = blockIdx.x;
    const int n_scan = layer == 0 ? NB * NTB : NB * 64;
    for (int r = bx; r < 512; r += G) { const int b = r >> 6, g = (r >> 5) & 1, qb = r & 31; attn_item(P, layer, 0, b, g, CTX + qb * 128, 4, NTB, 0, lds); }
    for (int r = bx; r < 512; r += G) { const int b = r >> 6, g = (r >> 5) & 1, qb = r & 31; const int qt = 4 + 2 * qb; int lo = qt - 2, hi = qt + 4; if (lo < 4) lo = 4; if (hi > NTB) hi = NTB;
        attn_item(P, layer, 1, b, g, CTX + qb * 128, lo, hi, 1, lds); }
    if (layer == 0) for (int r = rot((int)bx, 64, G); r < 64; r += G) { const int mix = r >> 5, b = (r >> 2) & 7, g = (r >> 1) & 1, qb = r & 1; attn_item(P, layer, mix, b, g, qb * 128, 4, 4, 0, lds); }
    for (int rr = rot((int)bx, 128, G); rr < n_scan; rr += G) { int b, tb; if (layer == 0) { b = rr / NTB; tb = rr % NTB; } else { b = rr >> 6; tb = 4 + (rr & 63); } mlstm_out_item(P, layer, b, tb, lds); }
    for (int rr = rot((int)bx, 96, G); rr < n_scan; rr += G) { int b, tb; if (layer == 0) { b = rr / NTB; tb = rr % NTB; } else { b = rr >> 6; tb = 4 + (rr & 63); } gla_out_item(P, layer, b, tb, lds); }
}

#define XB_TMO      128
#define XB_XCNT(j)  (256  + 64 * (j))
#define XB_XSUB(j)  (1280 + 64 * (j))
#define XB_XGEN(j)  (2304 + 64 * (j))
#define XB_TOP      3328
#define XB_TOPGEN   3392
#define XCD_BAR_WORDS 3456
#define XB_SPIN_CAP (1u << 22)
DI unsigned xb_ld(unsigned* p)              { return __hip_atomic_load(p, __ATOMIC_RELAXED, __HIP_MEMORY_SCOPE_AGENT); }
DI unsigned xb_add(unsigned* p, unsigned v) { return __hip_atomic_fetch_add(p, v, __ATOMIC_RELAXED, __HIP_MEMORY_SCOPE_AGENT); }
DI unsigned xb_xcc_id() { return (unsigned)__builtin_amdgcn_s_getreg((3 << 11) | 20) & 0xFu; }
#define XB_SPIN(cond, bar) do { unsigned _sp = 0; while (cond) { __builtin_amdgcn_s_sleep(1); \
    if ((++_sp & 255u) == 0u) { if (xb_ld(&(bar)[XB_TMO])) break; if (_sp > XB_SPIN_CAP) { atomicAdd(&(bar)[XB_TMO], 1u); break; } } } } while (0)
struct XcdBarrier { unsigned* bar; unsigned x; volatile LAS unsigned* st; };
DI XcdBarrier xcd_barrier_post(unsigned* bar, volatile LAS unsigned* st, bool t0) {
    XcdBarrier b; b.bar = bar; b.x = xb_xcc_id(); b.st = st;
    if (t0) (void)xb_add(&bar[XB_XCNT(b.x)], 1u);
    return b;
}
DI void xcd_barrier_complete(unsigned* bar, unsigned x, unsigned& nloc, unsigned& nx) {
    const unsigned G = gridDim.x;
    unsigned sum, cnt, mine, sp = 0u;
    for (;;) {
        sum = 0u; cnt = 0u; mine = 0u;
#pragma unroll
        for (unsigned j = 0; j < 16; ++j) { const unsigned c = xb_ld(&bar[XB_XCNT(j)]); sum += c; cnt += (c > 0u) ? 1u : 0u; mine = (j == x) ? c : mine; }
        if (sum == G) break;
        __builtin_amdgcn_s_sleep(1);
        if ((++sp & 255u) == 0u) { if (xb_ld(&bar[XB_TMO])) break; if (sp > XB_SPIN_CAP) { atomicAdd(&bar[XB_TMO], 1u); break; } }
    }
    nloc = mine > 0u ? mine : 1u; nx = cnt > 0u ? cnt : 1u;
}
DI void xcd_barrier(const XcdBarrier& b, int wv) {
    asm volatile("s_waitcnt vmcnt(0)" ::: "memory");
    __syncthreads();
    if (otid(wv) == 0) {
        unsigned* bar = b.bar;
        __builtin_amdgcn_s_waitcnt(0);
        unsigned nloc = b.st[0], nx = b.st[1];
        if (nloc == 0u) { xcd_barrier_complete(bar, b.x, nloc, nx); b.st[0] = nloc; b.st[1] = nx; }
        const unsigned old = xb_add(&bar[XB_XSUB(b.x)], 1u);
        const unsigned gen = old / nloc;
        if (old + 1u == (gen + 1u) * nloc) {
            __builtin_amdgcn_fence(__ATOMIC_RELEASE, "agent");
            asm volatile("s_waitcnt vmcnt(0)" ::: "memory");
            const unsigned og = xb_add(&bar[XB_TOP], 1u);
            const unsigned tg = og / nx;
            if (og + 1u == (tg + 1u) * nx) xb_add(&bar[XB_TOPGEN], 1u);
            else XB_SPIN(xb_ld(&bar[XB_TOPGEN]) == tg, bar);
            __builtin_amdgcn_fence(__ATOMIC_ACQUIRE, "agent");
            xb_add(&bar[XB_XGEN(b.x)], 1u);
            asm volatile("s_waitcnt vmcnt(0)" ::: "memory");
        } else {
            XB_SPIN(xb_ld(&bar[XB_XGEN(b.x)]) == gen, bar);
            __builtin_amdgcn_fence(__ATOMIC_ACQUIRE, "agent");
            asm volatile("s_waitcnt vmcnt(0)" ::: "memory");
        }
    }
    __syncthreads();
}

__global__ void __launch_bounds__(512, 2) fwd_megakernel(Params Pin) {
    KP P; (Params&)P = Pin; P.wv = __builtin_amdgcn_readfirstlane((int)threadIdx.x >> 6);
    extern __shared__ __attribute__((aligned(16))) unsigned char lds_raw[];
    LAS unsigned char* lds = (LAS unsigned char*)lds_raw;
    cg::grid_group grid = cg::this_grid();
    const int G = gridDim.x, bx = blockIdx.x;
    const float* MOD = (const float*)(P.ws + WS_MOD);
    volatile LAS unsigned* xst = (volatile LAS unsigned*)(lds + LDS_BYTES - 16);
    unsigned* barw = (unsigned*)(P.ws + WS_BAR);
    { const int t = otid(P.wv); if (t == 0) { xst[0] = 0u; xst[1] = 0u; }
      if (bx == 0) for (int i = t; i < XCD_BAR_WORDS; i += 512) barw[i] = 0u; }
    p0_phase(P, lds, 0);
    grid.sync();
    const XcdBarrier xb = xcd_barrier_post(barw, xst, otid(P.wv) == 0);
#define GSYNC() xcd_barrier(xb, P.wv)
    for (int layer = 0; layer < 2; ++layer) {
        const int skip = layer == 1;
        norm_phase(P, layer, 1, 0);
        GSYNC();
        { pg8::Gemm g{(const bf16_t*)(P.ws + WS_H), (const bf16_t*)(P.ws + WS_WIN) + (size_t)layer * ZW * D, D}; pg8::Order S; S.init(ZW / 256, G, bx, 0, D);
          pg8::EpiZ E{(bf16_t*)(P.ws + WS_Z), (float*)(P.ws + WS_GATE)}; pg8::gemm_phase(lds, g, S, E, P.wv); }
        GSYNC();
        prep_phase(P, layer, lds);
        GSYNC();
        chain_phase(P);
        if (layer == 0) p0_phase(P, lds, 1);
        GSYNC();
        mixer_phase(P, layer, lds);
        GSYNC();
        { pg8::Gemm g{(const bf16_t*)(P.ws + WS_O), (const bf16_t*)(P.ws + WS_WOUT) + (size_t)layer * D * D, D}; pg8::Order S; S.init(D / 256, G, bx, 1, D, layer == 0 ? 4 : 0);
          pg8::EpiRes E{P, layer == 0, MOD + (size_t)layer * 9 * 6144 + 2048}; pg8::gemm_phase(lds, g, S, E, P.wv); }
        GSYNC();
        norm_phase(P, layer, 2, skip);
        GSYNC();
        { pg8::Gemm g{(const bf16_t*)(P.ws + WS_H), (const bf16_t*)(P.ws + WS_W1) + (size_t)layer * FF * D, D}; pg8::Order S; S.init(FF / 256, G, bx, skip, D);
          pg8::EpiRelu2 E{(bf16_t*)(P.ws + WS_U1)}; pg8::gemm_phase(lds, g, S, E, P.wv); }
        GSYNC();
        { pg8::Gemm g{(const bf16_t*)(P.ws + WS_U1), (const bf16_t*)(P.ws + WS_W2) + (size_t)layer * D * FF, FF}; pg8::Order S; S.init(D / 256, G, bx, 1, FF, layer == 0 ? 8 : 0);
          pg8::EpiRes E{P, 0, MOD + (size_t)layer * 9 * 6144 + 5120}; pg8::gemm_phase(lds, g, S, E, P.wv); }
        if (layer == 0) GSYNC();
    }
}

extern "C" void kernel_launch(void* const* d_in, const int* in_sizes, int n_in, void* d_out, int out_size, void* d_ws, size_t ws_size, hipStream_t stream) {
    static int grid_blocks = 0;
    if (grid_blocks == 0) {
        if (n_in != 23 || ws_size < WS_END) { fprintf(stderr, "kernel_launch: unexpected n_in %d or ws_size %zu (need %zu)\n", n_in, ws_size, (size_t)WS_END); grid_blocks = -1; return; }
        int dev = 0, cus = 0, per_cu = 0;
        hipGetDevice(&dev);
        hipDeviceGetAttribute(&cus, hipDeviceAttributeMultiprocessorCount, dev);
        hipFuncSetAttribute((const void*)fwd_megakernel, hipFuncAttributeMaxDynamicSharedMemorySize, LDS_BYTES);
        hipOccupancyMaxActiveBlocksPerMultiprocessor(&per_cu, (const void*)fwd_megakernel, 512, LDS_BYTES);
        (void)per_cu;
        grid_blocks = cus;
        (void)hipGetLastError();
    }
    if (grid_blocks < 0) return;
    Params p{};
    const float** pp = (const float**)&p;
    for (int i = 0; i < 23; ++i) pp[i] = (const float*)d_in[i];
    p.out = (float*)d_out; p.ws = (unsigned char*)d_ws;
    void* args[] = {&p};
    hipError_t e = hipLaunchCooperativeKernel((const void*)fwd_megakernel, dim3(grid_blocks), dim3(512), args, LDS_BYTES, stream);
    if (e != hipSuccess) fprintf(stderr, "cooperative launch failed: %s (grid %d)\n", hipGetErrorString(e), grid_blocks);
}
```

```cpp
#include <hip/hip_runtime.h>
#include <hip/hip_cooperative_groups.h>
#include <cstdio>
#include <cstdint>
namespace cg = cooperative_groups;

#define DI __device__ __forceinline__
#define LAS __attribute__((address_space(3)))
typedef unsigned short bf16_t;
typedef short bf16x8 __attribute__((ext_vector_type(8)));
typedef float f32x4 __attribute__((ext_vector_type(4)));
typedef float f32x2 __attribute__((ext_vector_type(2)));
typedef float f32x16 __attribute__((ext_vector_type(16)));
typedef unsigned u32x4 __attribute__((ext_vector_type(4)));
typedef unsigned u32x2 __attribute__((ext_vector_type(2)));
typedef __bf16 bf2_t __attribute__((ext_vector_type(2)));

constexpr int D = 1024, NB = 8, SEQ = 4096, CTX = 256, TT = SEQ + CTX  , MROWS = NB * TT  ;
constexpr int ZW = 3072, FF = 4096, NTB = TT / 64  , INW = 2864;
constexpr float EPS = 1e-6f;
constexpr int C_QA = 0, C_KA = 256, C_VA = 384, C_QB = 512, C_KB = 768, C_VB = 896;
constexpr int C_QC = 1024, C_KC = 1152, C_VC = 1280, C_RC = 1536, C_GC = 1792;
constexpr int C_QD = 1824, C_KD = 2080, C_VD = 2336, C_OD = 2592, C_ID = 2848;
constexpr int LDS_BYTES = 147456;

constexpr size_t al256(size_t x) { return (x + 255) & ~(size_t)255; }
constexpr size_t WS_WIN = 0;
constexpr size_t WS_WOUT = WS_WIN + (size_t)2 * ZW * D * 2;
constexpr size_t WS_W1 = WS_WOUT + (size_t)2 * D * D * 2;
constexpr size_t WS_W2 = WS_W1 + (size_t)2 * FF * D * 2;
constexpr size_t WS_MOD = WS_W2 + (size_t)2 * FF * D * 2;
constexpr size_t WS_XC = WS_MOD + al256((size_t)2 * 9 * 6 * D * 4);
constexpr size_t WS_Z = WS_XC + (size_t)NB * CTX * D * 4;
constexpr size_t WS_O = WS_Z + (size_t)MROWS * ZW * 2;
constexpr size_t WS_H = WS_O + (size_t)MROWS * D * 2;
constexpr size_t WS_U1 = WS_Z;
constexpr size_t WS_SLAB = WS_H + (size_t)MROWS * D * 2;
constexpr size_t WS_BG = WS_H;
constexpr size_t WS_UGD = WS_BG + (size_t)MROWS * 256 * 4;
constexpr size_t WS_UGC = WS_UGD + (size_t)64 * NTB * 4096 * 2;
constexpr size_t WS_ZTC = WS_UGC + (size_t)64 * NTB * 2048 * 2;
constexpr size_t WS_ZTD = WS_ZTC + (size_t)NB * 384 * TT * 2;
constexpr size_t WS_VTAB = WS_ZTD + (size_t)NB * 512 * TT * 2;
constexpr size_t WS_GATE = WS_VTAB + (size_t)NB * 256 * TT * 2;
constexpr size_t WS_FG = WS_GATE + (size_t)MROWS * 48 * 4;
constexpr size_t WS_IG = WS_FG + (size_t)MROWS * 8 * 4;
constexpr size_t WS_DGC = WS_IG + (size_t)MROWS * 8 * 4;
constexpr size_t WS_NGD = WS_DGC + (size_t)64 * NTB * 32 * 4;
constexpr size_t WS_DGD = WS_NGD + (size_t)64 * NTB * 64 * 4;
constexpr size_t WS_BAR = WS_DGD + al256((size_t)64 * NTB * 4);
constexpr size_t WS_END = WS_BAR + 16384;
static_assert(WS_GATE >= WS_H + (size_t)MROWS * D * 2, "GATE must not alias H");
static_assert(WS_END <= (size_t)536870912, "workspace budget");

struct Params {
    const float *x, *c, *ctx, *c_ctx, *w_mod, *b_mod, *g_norm1, *g_norm2, *w_in, *g_q_a, *g_k_a, *g_q_b, *g_k_b, *sink_b,
        *w_gla_gate, *b_gla_gate, *g_gla_out, *b_mlstm_i, *b_mlstm_f, *g_mlstm_out, *w_out, *w_mlp1, *w_mlp2;
    float* out; unsigned char* ws;
};
struct KP : Params { int wv; };

DI unsigned pk2(float lo, float hi) { f32x2 v = {lo, hi}; bf2_t r = __builtin_convertvector(v, bf2_t); return __builtin_bit_cast(unsigned, r); }
DI bf16_t f2bf(float x) { return (bf16_t)(pk2(x, 0.f) & 0xffffu); }
DI float bflo(unsigned u) { return __uint_as_float(u << 16); }
DI float bfhi(unsigned u) { return __uint_as_float(u & 0xffff0000u); }
DI float bf2f(bf16_t h) { return __uint_as_float((unsigned)h << 16); }
DI float logsig(float x) { return fminf(x, 0.f) - __logf(1.f + __expf(-fabsf(x))); }
DI int crow(int i, int h) { return (i & 3) + 8 * (i >> 2) + 4 * h; }
#define MFMA32(a, b, c) __builtin_amdgcn_mfma_f32_32x32x16_bf16((a), (b), (c), 0, 0, 0)
DI bf16x8 as_bf8(u32x4 v) { return __builtin_bit_cast(bf16x8, v); }
DI f32x16 zero16() { f32x16 z;
#pragma unroll
    for (int i = 0; i < 16; ++i) z[i] = 0.f; return z; }
DI bf16x8 pack8(const f32x16& x, int s) {
    u32x4 p; p.x = pk2(x[8 * s], x[8 * s + 1]); p.y = pk2(x[8 * s + 2], x[8 * s + 3]); p.z = pk2(x[8 * s + 4], x[8 * s + 5]); p.w = pk2(x[8 * s + 6], x[8 * s + 7]);
    return as_bf8(p);
}
DI int otid(int wv) { int l; asm volatile("v_mbcnt_lo_u32_b32 %0, -1, 0\n\tv_mbcnt_hi_u32_b32 %0, -1, %0" : "=v"(l)); return wv * 64 + l; }
DI float shx(float v, int lane, int mask) { return __builtin_bit_cast(float, __builtin_amdgcn_ds_bpermute((lane ^ mask) << 2, __builtin_bit_cast(int, v))); }
DI int rot(int bx, int k, int G) { int r = bx + k; while (r >= G) r -= G; return r; }
typedef short s16x4 __attribute__((ext_vector_type(4)));
DI s16x4 trr(const LAS bf16_t* p) { return __builtin_amdgcn_ds_read_tr16_b64_v4i16((LAS s16x4*)p); }
DI bf16x8 cat4(s16x4 a, s16x4 b) { return __builtin_shufflevector(a, b, 0, 1, 2, 3, 4, 5, 6, 7); }
DI u32x4 ldg16(const void* p) { return *(const u32x4*)p; }
DI u32x2 ldg8(const void* p) { return *(const u32x2*)p; }

DI const float* xin_tile(const Params& P, int b, int tl  ) { return tl == 0 ? P.ctx + (size_t)b * CTX * D : P.x + ((size_t)b * SEQ + (size_t)(tl - 1) * 256) * D; }
DI float* xst_tile(const Params& P, int b, int tl) { return tl == 0 ? (float*)(P.ws + WS_XC) + (size_t)b * CTX * D : P.out + ((size_t)b * SEQ + (size_t)(tl - 1) * 256) * D; }

namespace pg8 {
constexpr int BM = 256, BK = 64, HALF = 128, HTB = HALF * BK * 2, STAGE_BYTES = 8 * HTB, NXCD = 8, WGM = 8;
DI int lds_byte(int r, int c) { const int st = (r >> 4) * 2 + (c >> 5), rr = r & 15, cc = c & 31, ob = rr * 64 + cc * 2; return st * 1024 + (ob ^ (((ob >> 9) & 1) << 5)); }
DI void stage_rc(int b, int& R, int& C) { const int st = b / 1024, sb = b % 1024, swz = sb ^ (((sb >> 9) & 1) << 5); R = (st >> 1) * 16 + swz / 64; C = (st & 1) * 32 + (swz % 64) / 2; }
DI int perm32(int rho) { const int n = rho >> 4, i = rho & 15; return 8 * (i >> 2) + 4 * n + (i & 3); }
struct Unit { int pm, pn, kofs, nt, split, sl; };
struct Gemm { const bf16_t* A; const bf16_t* Bt; int K; };
struct Order {
    int nM, nN, nwg, G, c, skip, ns, K;
    DI void init(int nN_, int G_, int c_, int skip_, int K_, int ns_ = 0) { skip = skip_; nM = skip_ ? 128 : 136; nN = nN_; nwg = nM * nN; G = G_; c = c_; ns = ns_; K = K_; }
    DI bool next(int i, Unit& u) const {
        const long L = (long)i * G + c;
        u.kofs = 0; u.nt = K / BK; u.split = 0; u.sl = 0;
        if (L >= nwg) { if (ns == 0) return false; const int j = (int)(L - nwg); if (j >= 8 * nN * ns) return false;
            const int sl = j % ns, cu = j / ns; u.pm = (cu / nN) * 17; u.pn = cu % nN; u.nt = K / BK / ns; u.kofs = sl * (K / ns); u.split = 1; u.sl = sl; return true; }
        int wgid = (int)L; { const int q = nwg / NXCD, r = nwg % NXCD, xcd = wgid % NXCD, off = wgid / NXCD; wgid = (xcd < r ? xcd * (q + 1) : r * (q + 1) + (xcd - r) * q) + off; }
        const int nig = WGM * nN, gid = wgid / nig, fm = gid * WGM, gsz = (nM - fm) < WGM ? (nM - fm) : WGM;
        int pm = fm + ((wgid % nig) % gsz); u.pn = (wgid % nig) / gsz;
        u.pm = skip ? pm + pm / 16 + 1 : pm; return true;
    }
};

template <class Epi>
DI void gemm_phase(LAS unsigned char* lds, const Gemm g, const Order& S, const Epi& E, const int wv) {
    const int tid = otid(wv), wid = wv, lane = tid & 63, wr = wid >> 2, wc = wid & 3, fr = lane & 15, fq = lane >> 4;
    const int K = g.K;
    unsigned voffA[2], voffB[2];
#pragma unroll
    for (int i = 0; i < 2; ++i) { int R, C; stage_rc(tid * 16 + i * 8192, R, C); const int Rb = Epi::PERM ? ((R & ~31) + perm32(R & 31)) : R;
        voffA[i] = (unsigned)(R * K + C) * 2u; voffB[i] = (unsigned)(Rb * K + C) * 2u; }
    const size_t kstep = (size_t)(BK * 2);
    const size_t hstep = (size_t)HALF * K * 2;
    const size_t tstep = 2 * hstep;
    const unsigned ldsw = (unsigned)wid * 1024u;
    const int aoff = lds_byte(wr * 64 + fr, fq * 8), boff = lds_byte(wc * 32 + fr, fq * 8);
#define PG8_SA(b, h) (((b) * 2 + (h)) * HTB)
#define PG8_SB(b, h) ((4 + (b) * 2 + (h)) * HTB)
#define PG8_STAGE(bufoff, gbase, voff) do { _Pragma("unroll") for (int _i = 0; _i < 2; ++_i) \
        __builtin_amdgcn_global_load_lds((const unsigned*)((const char*)(gbase) + (voff)[_i]), (LAS unsigned*)(lds + (bufoff) + ldsw + _i * 8192), 16, 0, 0); } while (0)
#define PG8_LDA(dst, b, h) do { _Pragma("unroll") for (int m = 0; m < 4; ++m) _Pragma("unroll") for (int k = 0; k < 2; ++k) dst[m][k] = *(const LAS bf16x8*)(lds + PG8_SA(b, h) + aoff + m * 2048 + k * 1024); } while (0)
#define PG8_LDB(dst, b, h) do { _Pragma("unroll") for (int n = 0; n < 2; ++n) _Pragma("unroll") for (int k = 0; k < 2; ++k) dst[n][k] = *(const LAS bf16x8*)(lds + PG8_SB(b, h) + boff + n * 2048 + k * 1024); } while (0)
#define PG8_MMA(ai, bj, At, Bt) do { __builtin_amdgcn_s_setprio(1); _Pragma("unroll") for (int m = 0; m < 4; ++m) _Pragma("unroll") for (int n = 0; n < 2; ++n) _Pragma("unroll") for (int k = 0; k < 2; ++k) \
        acc[ai][bj][m][n] = __builtin_amdgcn_mfma_f32_16x16x32_bf16(Bt[n][k], At[m][k], acc[ai][bj][m][n], 0, 0, 0); __builtin_amdgcn_s_setprio(0); } while (0)
#define PG8_WAIT_V(n) asm volatile("s_waitcnt vmcnt(" #n ")" ::: "memory")
#define PG8_WAIT_L(n) asm volatile("s_waitcnt lgkmcnt(" #n ")" ::: "memory")
#define PG8_BAR __builtin_amdgcn_s_barrier()
#define PG8_SCHED __builtin_amdgcn_sched_barrier(0)
    Unit cur, nxt; int ui = 0;
    if (!S.next(0, cur)) return;
    f32x4 acc[2][2][4][2];
#pragma unroll
    for (int a = 0; a < 2; ++a)
#pragma unroll
        for (int b = 0; b < 2; ++b)
#pragma unroll
            for (int m = 0; m < 4; ++m)
#pragma unroll
                for (int n = 0; n < 2; ++n) acc[a][b][m][n] = (f32x4){0.f, 0.f, 0.f, 0.f};
    bf16x8 At[4][2], B0[2][2], B1[2][2];
    const char* cA = (const char*)g.A + (size_t)cur.pm * tstep + (size_t)cur.kofs * 2; const char* cB = (const char*)g.Bt + (size_t)cur.pn * tstep + (size_t)cur.kofs * 2;
    PG8_STAGE(PG8_SB(0, 0), cB, voffB); PG8_STAGE(PG8_SB(0, 1), cB + hstep, voffB); PG8_STAGE(PG8_SA(0, 0), cA, voffA); PG8_STAGE(PG8_SA(0, 1), cA + hstep, voffA);
    if (wr == 1) PG8_BAR;
    PG8_WAIT_V(2); PG8_BAR;
    PG8_STAGE(PG8_SB(1, 0), cB + kstep, voffB); PG8_STAGE(PG8_SA(1, 0), cA + kstep, voffA); PG8_STAGE(PG8_SB(1, 1), cB + hstep + kstep, voffB);
    PG8_WAIT_V(6); PG8_BAR;
    for (;;) {
        const bool has_next = S.next(ui + 1, nxt);
        const char* nA = has_next ? (const char*)g.A + (size_t)nxt.pm * tstep + (size_t)nxt.kofs * 2 : cA; const char* nB = has_next ? (const char*)g.Bt + (size_t)nxt.pn * tstep + (size_t)nxt.kofs * 2 : cB;
        const int nt = cur.nt;
        for (int t = 0; t < nt; t += 2) {
            const bool last = (t == nt - 2);
            const char* a1 = cA + (size_t)(t + 1) * kstep;
            const char* a2 = last ? nA : cA + (size_t)(t + 2) * kstep; const char* b2 = last ? nB : cB + (size_t)(t + 2) * kstep;
            const char* a3 = a2 + kstep; const char* b3 = b2 + kstep;
            PG8_LDB(B0, 0, 0); PG8_LDB(B1, 0, 1); PG8_SCHED; PG8_LDA(At, 0, 0); PG8_STAGE(PG8_SA(1, 1), a1 + hstep, voffA);
            PG8_WAIT_V(8); PG8_WAIT_L(0); PG8_BAR; PG8_MMA(0, 0, At, B0); PG8_MMA(0, 1, At, B1); PG8_BAR; PG8_SCHED;
            PG8_LDA(At, 0, 1); PG8_STAGE(PG8_SB(0, 0), b2, voffB); PG8_STAGE(PG8_SB(0, 1), b2 + hstep, voffB); PG8_STAGE(PG8_SA(0, 0), a2, voffA);
            PG8_WAIT_V(8); PG8_WAIT_L(0); PG8_BAR; PG8_MMA(1, 0, At, B0); PG8_MMA(1, 1, At, B1); PG8_BAR; PG8_SCHED;
            PG8_LDB(B0, 1, 0); PG8_LDB(B1, 1, 1); PG8_SCHED; PG8_LDA(At, 1, 0); PG8_STAGE(PG8_SA(0, 1), a2 + hstep, voffA);
            PG8_WAIT_V(8); PG8_WAIT_L(0); PG8_BAR; PG8_MMA(0, 0, At, B0); PG8_MMA(0, 1, At, B1); PG8_BAR; PG8_SCHED;
            PG8_LDA(At, 1, 1); PG8_STAGE(PG8_SB(1, 0), b3, voffB); PG8_STAGE(PG8_SB(1, 1), b3 + hstep, voffB); PG8_STAGE(PG8_SA(1, 0), a3, voffA);
            PG8_WAIT_V(8); PG8_WAIT_L(0); PG8_BAR; PG8_MMA(1, 0, At, B0); PG8_MMA(1, 1, At, B1); PG8_BAR; PG8_SCHED;
        }
        if (wr == 0) PG8_BAR;
        E(acc, cur, wr, wc, fr, fq);
        if (!has_next) break;
#pragma unroll
        for (int a = 0; a < 2; ++a)
#pragma unroll
            for (int b = 0; b < 2; ++b)
#pragma unroll
                for (int m = 0; m < 4; ++m)
#pragma unroll
                    for (int n = 0; n < 2; ++n) acc[a][b][m][n] = (f32x4){0.f, 0.f, 0.f, 0.f};
        cur = nxt; cA = nA; cB = nB; ++ui;
        if (wr == 1) PG8_BAR;
    }
    PG8_WAIT_V(0);
    PG8_BAR;
#undef PG8_SA
#undef PG8_SB
#undef PG8_STAGE
#undef PG8_LDA
#undef PG8_LDB
#undef PG8_MMA
#undef PG8_WAIT_V
#undef PG8_WAIT_L
#undef PG8_BAR
#undef PG8_SCHED
}

struct EpiZ {
    static constexpr bool PERM = true;
    bf16_t* Z; float* GATE;
    DI void operator()(const f32x4 (&acc)[2][2][4][2], const Unit& u, int wr, int wc, int fr, int fq) const {
        const int row0 = u.pm * BM + wr * 64 + fr, col0 = u.pn * BM + wc * 32 + 8 * fq;
#pragma unroll
        for (int ai = 0; ai < 2; ++ai)
#pragma unroll
            for (int m = 0; m < 4; ++m) { const size_t row = (size_t)(row0 + ai * HALF + m * 16);
#pragma unroll
                for (int bj = 0; bj < 2; ++bj) { const int col = col0 + bj * HALF; const f32x4 v0 = acc[ai][bj][m][0], v1 = acc[ai][bj][m][1];
                    u32x4 w; w.x = pk2(v0[0], v0[1]); w.y = pk2(v0[2], v0[3]); w.z = pk2(v1[0], v1[1]); w.w = pk2(v1[2], v1[3]);
                    *(u32x4*)(Z + row * ZW + col) = w;
                    int gc = -1; if (col >= C_GC && col < C_GC + 32) gc = col - C_GC; else if (col >= C_ID && col < C_ID + 16) gc = 32 + col - C_ID;
                    if (gc >= 0) { float* gp = GATE + row * 48 + gc; *(f32x4*)gp = v0; *(f32x4*)(gp + 4) = v1; } } }
    }
};
struct EpiRelu2 {
    static constexpr bool PERM = true;
    bf16_t* U;
    DI void operator()(const f32x4 (&acc)[2][2][4][2], const Unit& u, int wr, int wc, int fr, int fq) const {
        const int row0 = u.pm * BM + wr * 64 + fr, col0 = u.pn * BM + wc * 32 + 8 * fq;
#pragma unroll
        for (int ai = 0; ai < 2; ++ai)
#pragma unroll
            for (int m = 0; m < 4; ++m) { const size_t row = (size_t)(row0 + ai * HALF + m * 16);
#pragma unroll
                for (int bj = 0; bj < 2; ++bj) { const int col = col0 + bj * HALF; f32x4 v0 = acc[ai][bj][m][0], v1 = acc[ai][bj][m][1];
#pragma unroll
                    for (int j = 0; j < 4; ++j) { const float a = fmaxf(v0[j], 0.f), b = fmaxf(v1[j], 0.f); v0[j] = a * a; v1[j] = b * b; }
                    u32x4 w; w.x = pk2(v0[0], v0[1]); w.y = pk2(v0[2], v0[3]); w.z = pk2(v1[0], v1[1]); w.w = pk2(v1[2], v1[3]);
                    *(u32x4*)(U + row * FF + col) = w; } }
    }
};
struct EpiRes {
    static constexpr bool PERM = true;
    Params P; int from_input; const float* ga;
    DI void operator()(const f32x4 (&acc)[2][2][4][2], const Unit& u, int wr, int wc, int fr, int fq) const {
        const int b = u.pm / 17, tl = u.pm % 17;
        const float* rbase = from_input ? xin_tile(P, b, tl) : xst_tile(P, b, tl);
        float* dbase = xst_tile(P, b, tl);
        const float* garow = ga + (size_t)(tl == 0 ? 8 : b) * 6144;
        const int rin = wr * 64 + fr, col0 = u.pn * BM + wc * 32 + 8 * fq;
#pragma unroll
        for (int bj = 0; bj < 2; ++bj) { const int col = col0 + bj * HALF; const f32x4 g0 = *(const f32x4*)(garow + col), g1 = *(const f32x4*)(garow + col + 4);
#pragma unroll
            for (int ai = 0; ai < 2; ++ai)
#pragma unroll
                for (int m = 0; m < 4; ++m) { const size_t off = (size_t)(rin + ai * HALF + m * 16) * D + col;
                    if (u.split) { float* sp = (float*)(P.ws + WS_SLAB) + ((size_t)u.sl * (NB * CTX) + (size_t)b * CTX) * D + off;
                        *(f32x4*)sp = g0 * acc[ai][bj][m][0]; *(f32x4*)(sp + 4) = g1 * acc[ai][bj][m][1]; }
                    else { const f32x4 x0 = *(const f32x4*)(rbase + off), x1 = *(const f32x4*)(rbase + off + 4);
                        *(f32x4*)(dbase + off) = x0 + g0 * acc[ai][bj][m][0]; *(f32x4*)(dbase + off + 4) = x1 + g1 * acc[ai][bj][m][1]; } } }
    }
};
}

DI void transpose_item(const int wv, const float* W, int K, int N, bf16_t* WT, int kb, int nb, LAS float* tile) {
    const int tid = otid(wv), k0 = kb * 64, n0 = nb * 256;
    { const int kk = tid >> 4, c4 = (tid & 15) * 4; f32x4 v[2][4];
#pragma unroll
      for (int i = 0; i < 2; ++i)
#pragma unroll
          for (int j = 0; j < 4; ++j) { const int n = n0 + c4 + 64 * j; v[i][j] = (f32x4){0.f, 0.f, 0.f, 0.f}; if (n < N) v[i][j] = *(const f32x4*)(W + (size_t)(k0 + kk + 32 * i) * N + n); }
#pragma unroll
      for (int i = 0; i < 2; ++i)
#pragma unroll
          for (int j = 0; j < 4; ++j) { LAS float* tp = tile + (kk + 32 * i) * 257 + c4 + 64 * j; tp[0] = v[i][j][0]; tp[1] = v[i][j][1]; tp[2] = v[i][j][2]; tp[3] = v[i][j][3]; } }
    __syncthreads();
    { const int kc = (tid & 7) * 8;
#pragma unroll
      for (int j = 0; j < 4; ++j) { const int n = (tid >> 3) + 64 * j; const LAS float* s = tile + kc * 257 + n;
          u32x4 o; o.x = pk2(s[0], s[257]); o.y = pk2(s[2 * 257], s[3 * 257]); o.z = pk2(s[4 * 257], s[5 * 257]); o.w = pk2(s[6 * 257], s[7 * 257]);
          *(u32x4*)(WT + (size_t)(n0 + n) * K + k0 + kc) = o; } }
    __syncthreads();
}
DI void mod_item(const KP& P, int l, int nc, LAS float* S  , LAS float* red  ) {
    const int tid = otid(P.wv);
    for (int idx = tid; idx < 9 * D; idx += 512) { const int r = idx >> 10, k = idx & 1023; const float v = r < 8 ? P.c[r * D + k] : P.c_ctx[k]; S[idx] = v / (1.f + expf(-v)); }
    __syncthreads();
    const int col = tid % 48, kq = tid / 48, n0 = nc * 48;
    if (kq < 8) {
        float a[9];
#pragma unroll
        for (int r = 0; r < 9; ++r) a[r] = 0.f;
        const float* w = P.w_mod + (size_t)l * D * 6144 + n0 + col;
#pragma unroll 4
        for (int k = kq * 128; k < kq * 128 + 128; ++k) { const float wv = w[(size_t)k * 6144];
#pragma unroll
            for (int r = 0; r < 9; ++r) a[r] += S[r * D + k] * wv; }
#pragma unroll
        for (int r = 0; r < 9; ++r) red[(kq * 9 + r) * 48 + col] = a[r];
    }
    __syncthreads();
    float* MOD = (float*)(P.ws + WS_MOD);
    if (tid < 9 * 48) { const int r = tid / 48, cc = tid % 48; float s = P.b_mod[l * 6144 + n0 + cc];
#pragma unroll
        for (int q = 0; q < 8; ++q) s += red[(q * 9 + r) * 48 + cc];
        MOD[((size_t)l * 9 + r) * 6144 + n0 + cc] = s; }
    __syncthreads();
}
DI void p0_phase(const KP& P, LAS unsigned char* lds, const int lsel  ) {
    const int G = gridDim.x;
    LAS float* lf = (LAS float*)lds;
    if (lsel == 0) for (int it = blockIdx.x; it < 256; it += G) mod_item(P, it >> 7, it & 127, lf, lf + 9 * D);
    if (lsel == 0) { float* XC = (float*)(P.ws + WS_XC); const int gt = blockIdx.x * 512 + otid(P.wv);
      for (int i = gt; i < NB * CTX * D / 4; i += G * 512) ((f32x4*)XC)[i] = ((const f32x4*)P.ctx)[i]; }
    constexpr int I_IN = 16 * 12, I_OUT = 16 * 4, I_1 = 16 * 16, I_2 = 64 * 4, PER = I_IN + I_OUT + I_1 + I_2;
    for (int it = rot((int)blockIdx.x, 160, G); it < PER; it += G) {
        const int l = lsel; int r = it;
        if (r < I_IN) { transpose_item(P.wv, P.w_in + (size_t)l * D * INW, D, INW, (bf16_t*)(P.ws + WS_WIN) + (size_t)l * ZW * D, r / 12, r % 12, lf); continue; } r -= I_IN;
        if (r < I_OUT) { transpose_item(P.wv, P.w_out + (size_t)l * D * D, D, D, (bf16_t*)(P.ws + WS_WOUT) + (size_t)l * D * D, r / 4, r % 4, lf); continue; } r -= I_OUT;
        if (r < I_1) { transpose_item(P.wv, P.w_mlp1 + (size_t)l * D * FF, D, FF, (bf16_t*)(P.ws + WS_W1) + (size_t)l * FF * D, r / 16, r % 16, lf); continue; } r -= I_1;
        transpose_item(P.wv, P.w_mlp2 + (size_t)l * FF * D, FF, D, (bf16_t*)(P.ws + WS_W2) + (size_t)l * D * FF, r / 4, r % 4, lf);
    }
}

DI void norm_phase(const KP& P, int layer, int which  , int skip_ctx) {
    const int tid = otid(P.wv), lane = tid & 63, wave = tid >> 6;
    const int gw = blockIdx.x * 8 + wave, NGW = gridDim.x * 8;
    const float* MOD = (const float*)(P.ws + WS_MOD);
    bf16_t* H = (bf16_t*)(P.ws + WS_H);
    const float* g = (which == 1 ? P.g_norm1 : P.g_norm2) + layer * D;
    const int nslab = (layer == 0 && which == 2) ? 4 : (layer == 1 && which == 1) ? 8 : 0;
    for (int R = gw; R < MROWS; R += NGW) {
        const int b = R / TT, t = R % TT;
        if (skip_ctx && t < CTX) continue;
        const int tl = t < CTX ? 0 : 1 + ((t - CTX) >> 8), rin = t < CTX ? t : ((t - CTX) & 255);
        const float* src = ((which == 1 && layer == 0) ? xin_tile(P, b, tl) : xst_tile(P, b, tl)) + (size_t)rin * D;
        const float* mrow = MOD + ((size_t)layer * 9 + (t < CTX ? 8 : b)) * 6144 + (which == 1 ? 0 : 3072);
        f32x4 v[4]; float ss = 0.f;
#pragma unroll
        for (int j = 0; j < 4; ++j) v[j] = *(const f32x4*)(src + 8 * lane + 512 * (j >> 1) + 4 * (j & 1));
        if (nslab && t < CTX) { const float* sl = (const float*)(P.ws + WS_SLAB) + ((size_t)b * CTX + t) * D + 8 * lane;
            for (int s = 0; s < nslab; ++s)
#pragma unroll
                for (int j = 0; j < 4; ++j) v[j] = v[j] + *(const f32x4*)(sl + (size_t)s * (NB * CTX) * D + 512 * (j >> 1) + 4 * (j & 1));
            if (which == 2) { float* dst = xst_tile(P, b, 0) + (size_t)rin * D + 8 * lane;
#pragma unroll
                for (int j = 0; j < 4; ++j) *(f32x4*)(dst + 512 * (j >> 1) + 4 * (j & 1)) = v[j]; } }
#pragma unroll
        for (int j = 0; j < 4; ++j) { ss += v[j][0] * v[j][0] + v[j][1] * v[j][1] + v[j][2] * v[j][2] + v[j][3] * v[j][3]; }
#pragma unroll
        for (int o = 1; o < 64; o <<= 1) ss += shx(ss, lane, o);
        const float rstd = rsqrtf(ss * (1.f / D) + EPS);
#pragma unroll
        for (int jj = 0; jj < 2; ++jj) { u32x4 o;
#pragma unroll
            for (int hh = 0; hh < 2; ++hh) { const int j = 2 * jj + hh, col = 8 * lane + 512 * jj + 4 * hh;
                const f32x4 gg = *(const f32x4*)(g + col), sh = *(const f32x4*)(mrow + col), sc = *(const f32x4*)(mrow + 1024 + col);
                f32x4 y;
#pragma unroll
                for (int e = 0; e < 4; ++e) y[e] = v[j][e] * rstd * gg[e] * (1.f + sc[e]) + sh[e];
                if (hh == 0) { o.x = pk2(y[0], y[1]); o.y = pk2(y[2], y[3]); } else { o.z = pk2(y[0], y[1]); o.w = pk2(y[2], y[3]); } }
            *(u32x4*)(H + (size_t)R * D + 8 * lane + 512 * jj) = o; }
    }
}

DI void attn_prep_item(const KP& P, int layer, int b, int tb, LAS unsigned char* lds) {
    const int tid = otid(P.wv), lane = tid & 63, wave = tid >> 6;
    bf16_t* Z = (bf16_t*)(P.ws + WS_Z);
    const int t0 = tb * 64; const size_t R0 = (size_t)b * TT + t0;
    { const int p = lane & 31, hv = lane >> 5, fi = p & 15;
      const float inv = exp2f(-(float)fi * (13.287712379549449f / 16.f));
      float gk_a[2], gk_b[2];
#pragma unroll
      for (int e = 0; e < 2; ++e) { gk_a[e] = P.g_k_a[layer * 64 + 2 * p + e]; gk_b[e] = P.g_k_b[layer * 64 + 2 * p + e]; }
      unsigned uu[8][2];
#pragma unroll
      for (int ti = 0; ti < 8; ++ti)
#pragma unroll
          for (int i = 0; i < 2; ++i) { const int cb = (i ? C_KB : C_KA) + 64 * hv; uu[ti][i] = *(const unsigned*)(Z + (R0 + wave * 8 + ti) * ZW + cb + 2 * p); }
#pragma unroll
      for (int ti = 0; ti < 8; ++ti) { const int t = t0 + wave * 8 + ti; bf16_t* zr = Z + (R0 + wave * 8 + ti) * ZW;
          float cs = 1.f, sn = 0.f;
          if (t >= CTX) { const int tl = t - CTX; const float pos = (float)(p < 16 ? (tl >> 6) : (tl & 63)); const float ang = pos * inv; cs = __cosf(ang); sn = __sinf(ang); }
#pragma unroll
          for (int i = 0; i < 2; ++i) { const int cb = (i ? C_KB : C_KA) + 64 * hv;
              const float g0 = i ? gk_b[0] : gk_a[0], g1 = i ? gk_b[1] : gk_a[1];
              const unsigned u = uu[ti][i]; const float x1 = bflo(u), x2 = bfhi(u);
              float ss = x1 * x1 + x2 * x2;
#pragma unroll
              for (int o = 1; o < 32; o <<= 1) ss += shx(ss, lane, o);
              const float rstd = rsqrtf(ss * (1.f / 64.f) + EPS);
              const float y1 = x1 * rstd * g0, y2 = x2 * rstd * g1;
              *(unsigned*)(zr + cb + 2 * p) = pk2(y1 * cs - y2 * sn, y1 * sn + y2 * cs); } } }
}

DI void gla_prep_item(const KP& P, int layer, int b, int tb, LAS unsigned char* lds) {
    const int tid = otid(P.wv), lane = tid & 63, wave = tid >> 6, r = lane & 31, h = lane >> 5;
    const bf16_t* Z = (const bf16_t*)(P.ws + WS_Z); const float* GATE = (const float*)(P.ws + WS_GATE);
    const int t0 = tb * 64; const size_t R0 = (size_t)b * TT + t0;
    constexpr int KP_ = 144, VP = 272;
    LAS bf16_t* Kt = (LAS bf16_t*)lds;
    LAS bf16_t* Vt = (LAS bf16_t*)(lds + 18432);
    LAS float* Bc = (LAS float*)(lds + 53248);
    LAS float* Gt = (LAS float*)(lds + 118784);
    { u32x4 kv[2], vv[4];
#pragma unroll
      for (int i = 0; i < 2; ++i) { const int q = tid + 512 * i, row = q >> 4, ch = q & 15; kv[i] = ldg16(Z + (R0 + row) * ZW + C_KC + ch * 8); }
#pragma unroll
      for (int i = 0; i < 4; ++i) { const int q = tid + 512 * i, row = q >> 5, ch = q & 31; vv[i] = ldg16(Z + (R0 + row) * ZW + C_VC + ch * 8); }
      const int tok = tid >> 3, c4 = (tid & 7) * 4; const f32x4 gv = *(const f32x4*)(GATE + (R0 + tok) * 48 + c4);
#pragma unroll
      for (int i = 0; i < 2; ++i) { const int q = tid + 512 * i, row = q >> 4, ch = q & 15; *(LAS u32x4*)(Kt + row * KP_ + ch * 8) = kv[i]; }
#pragma unroll
      for (int i = 0; i < 4; ++i) { const int q = tid + 512 * i, row = q >> 5, ch = q & 31; *(LAS u32x4*)(Vt + row * VP + ch * 8) = vv[i]; }
      *(LAS f32x4*)(Gt + tok * 32 + c4) = gv; }
    __syncthreads();
    float* BG = (float*)(P.ws + WS_BG);
    { const int dc = tid & 255, dir = dc >> 7, ch = dc & 127;
      float w[16];
#pragma unroll
      for (int k = 0; k < 16; ++k) w[k] = P.w_gla_gate[(((size_t)layer * 2 + dir) * 16 + k) * 128 + ch];
      const float bias = P.b_gla_gate[(layer * 2 + dir) * 128 + ch];
      for (int i = 0; i < 32; ++i) { const int t = (tid >> 8) + 2 * i; float pre = bias;
#pragma unroll
          for (int k = 0; k < 16; ++k) pre += Gt[t * 32 + dir * 16 + k] * w[k];
          Bc[(dir * 64 + t) * 128 + ch] = logsig(pre) * (1.f / 16.f); } }
    __syncthreads();
    if (tid < 256) { const int dir = tid >> 7, ch = tid & 127; float run = 0.f;
        for (int step = 0; step < 64; ++step) { const int t = dir ? 63 - step : step;
            run += Bc[(dir * 64 + t) * 128 + ch]; Bc[(dir * 64 + t) * 128 + ch] = run; BG[(R0 + t) * 256 + dir * 128 + ch] = run; } }
    __syncthreads();
    { const int hd = wave & 3, dir = wave >> 2;
      const float be = Bc[(dir * 64 + (dir ? 0 : 63)) * 128 + hd * 32 + r];
      const int qq = (lane & 15) >> 2, pp = lane & 3, blk = (lane >> 4) & 1;
      const int vtrK = (8 * h + qq) * KP_ + 16 * blk + 4 * pp + hd * 32, vtrV = (8 * h + qq) * VP + 16 * blk + 4 * pp + hd * 64;
      f32x16 acc[2]; acc[0] = zero16(); acc[1] = zero16();
#pragma unroll
      for (int kk = 0; kk < 4; ++kk) { const int s0 = 16 * kk + 8 * h;
          const s16x4 klo = trr(Kt + vtrK + 16 * kk * KP_), khi = trr(Kt + vtrK + (16 * kk + 4) * KP_);
          float kw[8];
#pragma unroll
          for (int j = 0; j < 4; ++j) { kw[j] = bf2f((bf16_t)klo[j]) * __expf(be - Bc[(dir * 64 + s0 + j) * 128 + hd * 32 + r]); kw[4 + j] = bf2f((bf16_t)khi[j]) * __expf(be - Bc[(dir * 64 + s0 + 4 + j) * 128 + hd * 32 + r]); }
          u32x4 bp; bp.x = pk2(kw[0], kw[1]); bp.y = pk2(kw[2], kw[3]); bp.z = pk2(kw[4], kw[5]); bp.w = pk2(kw[6], kw[7]);
#pragma unroll
          for (int mt = 0; mt < 2; ++mt) { const LAS bf16_t* vp = Vt + vtrV + 16 * kk * VP + 32 * mt; acc[mt] = MFMA32(cat4(trr(vp), trr(vp + 4 * VP)), as_bf8(bp), acc[mt]); } }
      const int chain = (b * 2 + dir) * 4 + hd, c = dir ? (tb < 4 ? 3 - tb : 71 - tb) : tb;
      bf16_t* UG = (bf16_t*)(P.ws + WS_UGC) + ((size_t)chain * NTB + c) * 2048;
#pragma unroll
      for (int mt = 0; mt < 2; ++mt)
#pragma unroll
          for (int i = 0; i < 16; ++i) UG[(32 * mt + crow(i, h)) * 32 + r] = f2bf(acc[mt][i]);
      if (h == 0) ((float*)(P.ws + WS_DGC))[((size_t)chain * NTB + c) * 32 + r] = __expf(be); }
    __syncthreads();
}

DI void mlstm_prep_item(const KP& P, int layer, int b, int tb, LAS unsigned char* lds) {
    const int tid = otid(P.wv), lane = tid & 63, wave = tid >> 6, r = lane & 31, h = lane >> 5;
    const bf16_t* Z = (const bf16_t*)(P.ws + WS_Z); const float* GATE = (const float*)(P.ws + WS_GATE);
    const int t0 = tb * 64; const size_t R0 = (size_t)b * TT + t0;
    constexpr int VP = 272;
    LAS bf16_t* Kt = (LAS bf16_t*)lds;
    LAS bf16_t* Vt = (LAS bf16_t*)(lds + 34816);
    LAS float* Fl = (LAS float*)(lds + 69632);
    LAS float* Il = Fl + 512;
    LAS float* Gt = Il + 512;
    { u32x4 kv[4], vv[4];
#pragma unroll
      for (int i = 0; i < 4; ++i) { const int q = tid + 512 * i, row = q >> 5, ch = q & 31; const bf16_t* zr = Z + (R0 + row) * ZW + ch * 8; kv[i] = ldg16(zr + C_KD); vv[i] = ldg16(zr + C_VD); }
      f32x4 gv = {0.f, 0.f, 0.f, 0.f};
      if (tid < 256) { const int tok = tid >> 2, c4 = (tid & 3) * 4; gv = *(const f32x4*)(GATE + (R0 + tok) * 48 + 32 + c4); }
#pragma unroll
      for (int i = 0; i < 4; ++i) { const int q = tid + 512 * i, row = q >> 5, ch = q & 31; *(LAS u32x4*)(Kt + row * VP + ch * 8) = kv[i]; *(LAS u32x4*)(Vt + row * VP + ch * 8) = vv[i]; }
      if (tid < 256) { const int tok = tid >> 2, c4 = (tid & 3) * 4; *(LAS f32x4*)(Gt + tok * 16 + c4) = gv; } }
    __syncthreads();
    { const int t = tid >> 3, gi = tid & 7;
      Il[gi * 64 + t] = Gt[t * 16 + gi] + P.b_mlstm_i[layer * 8 + gi]; Fl[gi * 64 + t] = logsig(Gt[t * 16 + 8 + gi] + P.b_mlstm_f[layer * 8 + gi]); }
    __syncthreads();
    if (tid < 8) { const int dir = tid >> 2;
        float* FG = (float*)(P.ws + WS_FG); float* IG = (float*)(P.ws + WS_IG);
        float run = 0.f;
        for (int step = 0; step < 64; ++step) { const int t = dir ? 63 - step : step;
            run += Fl[tid * 64 + t]; Fl[tid * 64 + t] = run; FG[(R0 + t) * 8 + tid] = run; IG[(R0 + t) * 8 + tid] = Il[tid * 64 + t] - run; } }
    __syncthreads();
    { const int hd = wave & 3, dir = wave >> 2, gi = dir * 4 + hd;
      const float Fend = Fl[gi * 64 + (dir ? 0 : 63)];
      const int vtr = (8 * h + ((lane & 15) >> 2)) * VP + 16 * ((lane >> 4) & 1) + 4 * (lane & 3) + hd * 64;
      f32x16 acc[2][2]; acc[0][0] = zero16(); acc[0][1] = zero16(); acc[1][0] = zero16(); acc[1][1] = zero16();
      float nsum[2] = {0.f, 0.f};
#pragma unroll
      for (int kk = 0; kk < 4; ++kk) { const int s0 = 16 * kk + 8 * h;
          float wts[8];
#pragma unroll
          for (int j = 0; j < 8; ++j) wts[j] = __expf(Fend - Fl[gi * 64 + s0 + j] + Il[gi * 64 + s0 + j]) * 0.125f;
          u32x4 bp[2];
#pragma unroll
          for (int nt = 0; nt < 2; ++nt) { const LAS bf16_t* kp = Kt + vtr + 16 * kk * VP + 32 * nt; const s16x4 klo = trr(kp), khi = trr(kp + 4 * VP);
              float kw[8];
#pragma unroll
              for (int j = 0; j < 4; ++j) { kw[j] = bf2f((bf16_t)klo[j]) * wts[j]; kw[4 + j] = bf2f((bf16_t)khi[j]) * wts[4 + j]; nsum[nt] += kw[j] + kw[4 + j]; }
              bp[nt].x = pk2(kw[0], kw[1]); bp[nt].y = pk2(kw[2], kw[3]); bp[nt].z = pk2(kw[4], kw[5]); bp[nt].w = pk2(kw[6], kw[7]); }
#pragma unroll
          for (int mt = 0; mt < 2; ++mt) { const LAS bf16_t* vp = Vt + vtr + 16 * kk * VP + 32 * mt; const bf16x8 av = cat4(trr(vp), trr(vp + 4 * VP));
#pragma unroll
              for (int nt = 0; nt < 2; ++nt) acc[mt][nt] = MFMA32(av, as_bf8(bp[nt]), acc[mt][nt]); } }
      const int chain = (b * 2 + dir) * 4 + hd, c = dir ? (tb < 4 ? 3 - tb : 71 - tb) : tb;
      bf16_t* UG = (bf16_t*)(P.ws + WS_UGD) + ((size_t)chain * NTB + c) * 4096;
#pragma unroll
      for (int mt = 0; mt < 2; ++mt)
#pragma unroll
          for (int nt = 0; nt < 2; ++nt)
#pragma unroll
              for (int i = 0; i < 16; ++i) UG[(32 * mt + crow(i, h)) * 64 + 32 * nt + r] = f2bf(acc[mt][nt][i]);
#pragma unroll
      for (int nt = 0; nt < 2; ++nt) { nsum[nt] += shx(nsum[nt], lane, 32); if (h == 0) ((float*)(P.ws + WS_NGD))[((size_t)chain * NTB + c) * 64 + 32 * nt + r] = nsum[nt]; }
      if (lane == 0) ((float*)(P.ws + WS_DGD))[(size_t)chain * NTB + c] = __expf(Fend); }
    __syncthreads();
}

DI void prep_phase(const KP& P, int layer, LAS unsigned char* lds) {
    const int G = gridDim.x; constexpr int NBT = NB * NTB;
    for (int it = blockIdx.x; it < NBT; it += G) mlstm_prep_item(P, layer, it / NTB, it % NTB, lds);
    for (int it = rot((int)blockIdx.x, 224, G); it < NBT; it += G) gla_prep_item(P, layer, it / NTB, it % NTB, lds);
    for (int it = rot((int)blockIdx.x, 192, G); it < NBT; it += G) attn_prep_item(P, layer, it / NTB, it % NTB, lds);
}

DI void chain_phase(const KP& P) {
    const int gt = blockIdx.x * 512 + otid(P.wv), GS = gridDim.x * 512;
    bf16_t* UC = (bf16_t*)(P.ws + WS_UGC); const float* DC = (const float*)(P.ws + WS_DGC);
    bf16_t* UD = (bf16_t*)(P.ws + WS_UGD); const float* DD = (const float*)(P.ws + WS_DGD); float* NG = (float*)(P.ws + WS_NGD);
    for (int e = gt; e < 64 * 2048; e += GS) { const int chain = e >> 11, idx = e & 2047, d = idx & 31; float s = 0.f;
#pragma unroll 1
        for (int c0 = 0; c0 < NTB; c0 += 17) { float u[17], dc[17];
#pragma unroll
            for (int j = 0; j < 17; ++j) { const size_t p = (size_t)chain * NTB + c0 + j; u[j] = bf2f(UC[p * 2048 + idx]); dc[j] = DC[p * 32 + d]; }
#pragma unroll
            for (int j = 0; j < 17; ++j) { const size_t p = (size_t)chain * NTB + c0 + j; UC[p * 2048 + idx] = f2bf(s); s = dc[j] * s + u[j]; } } }
    for (int e = gt; e < 64 * 4096; e += GS) { const int chain = e >> 12, idx = e & 4095; float s = 0.f;
#pragma unroll 1
        for (int c0 = 0; c0 < NTB; c0 += 17) { float u[17], dc[17];
#pragma unroll
            for (int j = 0; j < 17; ++j) { const size_t p = (size_t)chain * NTB + c0 + j; u[j] = bf2f(UD[p * 4096 + idx]); dc[j] = DD[p]; }
#pragma unroll
            for (int j = 0; j < 17; ++j) { const size_t p = (size_t)chain * NTB + c0 + j; UD[p * 4096 + idx] = f2bf(s); s = dc[j] * s + u[j]; } } }
    for (int e = gt; e < 64 * 64; e += GS) { const int chain = e >> 6, idx = e & 63; float s = 0.f;
#pragma unroll 1
        for (int c0 = 0; c0 < NTB; c0 += 17) { float u[17], dc[17];
#pragma unroll
            for (int j = 0; j < 17; ++j) { const size_t p = (size_t)chain * NTB + c0 + j; u[j] = NG[p * 64 + idx]; dc[j] = DD[p]; }
#pragma unroll
            for (int j = 0; j < 17; ++j) { const size_t p = (size_t)chain * NTB + c0 + j; NG[p * 64 + idx] = s; s = dc[j] * s + u[j]; } } }
}

DI void attn_item(const KP& P, int layer, int mix  , int b, int g, int q0  , int lo, int hi, int window, LAS unsigned char* lds) {
    const int tid = otid(P.wv), lane = tid & 63, wave = tid >> 6, r = lane & 31, h = lane >> 5;
    const bf16_t* Z = (const bf16_t*)(P.ws + WS_Z); bf16_t* O = (bf16_t*)(P.ws + WS_O);
    const int head = g * 2 + (wave >> 2), tq = q0 + 32 * (wave & 3) + r;
    const int qcol = mix ? C_QB : C_QA, kcol = (mix ? C_KB : C_KA) + g * 64;
    const size_t Rb = (size_t)b * TT;
    LAS bf16_t* Kt = (LAS bf16_t*)lds;
    LAS bf16_t* Vt = (LAS bf16_t*)(lds + 18432);
    constexpr int KB_ = 64 * 72, VB_ = 64 * 72;
    const int vtr = (4 * h + ((lane & 15) >> 2)) * 72 + 16 * ((lane >> 4) & 1) + 4 * (lane & 3);
    bf16x8 Qf[4];
    const float QS = 0.18033688011112042f;
    { u32x4 qr[4]; float ss = 0.f;
#pragma unroll
      for (int kk = 0; kk < 4; ++kk) { qr[kk] = ldg16(Z + (Rb + tq) * ZW + qcol + head * 64 + 16 * kk + 8 * h);
#pragma unroll
          for (int j = 0; j < 4; ++j) { const float x1 = bflo(qr[kk][j]), x2 = bfhi(qr[kk][j]); ss += x1 * x1 + x2 * x2; } }
      ss += shx(ss, lane, 32);
      const float rstd = rsqrtf(ss * (1.f / 64.f) + EPS);
      const float* gq = (mix ? P.g_q_b : P.g_q_a) + layer * 64;
      const bool rope = tq >= CTX; const int tl = tq - CTX; const float prow = (float)(tl >> 6), pcol = (float)(tl & 63);
#pragma unroll
      for (int kk = 0; kk < 4; ++kk) { const f32x4 g0 = *(const f32x4*)(gq + 16 * kk + 8 * h), g1 = *(const f32x4*)(gq + 16 * kk + 8 * h + 4);
          const float gg[8] = {g0[0], g0[1], g0[2], g0[3], g1[0], g1[1], g1[2], g1[3]};
          u32x4 o;
#pragma unroll
          for (int j = 0; j < 4; ++j) { const int fi = 8 * (kk & 1) + 4 * h + j;
              float cs = 1.f, sn = 0.f;
              if (rope) { const float ang = (kk < 2 ? prow : pcol) * exp2f(-(float)fi * (13.287712379549449f / 16.f)); cs = __cosf(ang); sn = __sinf(ang); }
              const float y1 = bflo(qr[kk][j]) * rstd * gg[2 * j] * QS, y2 = bfhi(qr[kk][j]) * rstd * gg[2 * j + 1] * QS;
              o[j] = pk2(y1 * cs - y2 * sn, y1 * sn + y2 * cs); }
          Qf[kk] = as_bf8(o); } }
    float m, l = 0.f;
    { float gq = fabsf(((mix ? P.g_q_b : P.g_q_a) + layer * 64)[lane]), gk = fabsf(((mix ? P.g_k_b : P.g_k_a) + layer * 64)[lane]);
#pragma unroll
      for (int o = 1; o < 64; o <<= 1) { gq = fmaxf(gq, shx(gq, lane, o)); gk = fmaxf(gk, shx(gk, lane, o)); }
      m = fminf(8.f * 1.02f * gq * gk * 1.4426950408889634f, 40.f); }
    if (mix) { const float sk = P.sink_b[layer * 4 + head] * 1.4426950408889634f; m = fmaxf(m, sk); l = h ? 0.f : __builtin_amdgcn_exp2f(sk - m); }
    f32x16 accO[2]; accO[0] = zero16(); accO[1] = zero16();
    f32x16 negm;
#pragma unroll
    for (int i = 0; i < 16; ++i) negm[i] = -m;
    const int ntiles = 4 + (hi - lo);
    const int srow = tid >> 3, sch = (tid & 7) * 8;
    const bf16_t* kbase = Z + (Rb + srow) * ZW + kcol + sch;
    const bf16_t* vbase = Z + (Rb + srow) * ZW + (mix ? C_VB : C_VA) + g * 64 + sch;
#define TILE_KEY(i) (((i) < 4 ? (i) : lo + (i) - 4) * 64)
#define LOADK(i, kr) do { const int i_ = (i) < ntiles ? (i) : ntiles - 1; kr = ldg16(kbase + (size_t)TILE_KEY(i_) * ZW); } while (0)
#define LOADV(i, vr) do { const int i_ = (i) < ntiles ? (i) : ntiles - 1; vr = ldg16(vbase + (size_t)TILE_KEY(i_) * ZW); } while (0)
#define STOREK(i, buf, kr) do { if ((i) < ntiles) *(LAS u32x4*)(Kt + (buf) * KB_ + srow * 72 + sch) = kr; } while (0)
#define STOREV(i, buf, vr) do { if ((i) < ntiles) *(LAS u32x4*)(Vt + (buf) * VB_ + srow * 72 + sch) = vr; } while (0)
#define QK(dst, buf) do { const LAS bf16_t* Kc = Kt + (buf) * KB_; \
        _Pragma("unroll") for (int jt = 0; jt < 2; ++jt) { dst[jt] = negm; \
            _Pragma("unroll") for (int kk = 0; kk < 4; ++kk) { const bf16x8 a = *(const LAS bf16x8*)(Kc + (32 * jt + r) * 72 + 16 * kk + 8 * h); dst[jt] = MFMA32(a, Qf[kk], dst[jt]); } } } while (0)
#define TILE_STEP(it_, p_, kLd, vLd, kSt, vSt) do { \
        const int it = (it_); \
        LOADK(it + 3, kLd); LOADV(it + 2, vLd); \
        f32x16 Sn[2]; \
        if (window && it >= 4) { const int ktile = lo + it - 4; \
            _Pragma("unroll") for (int jt = 0; jt < 2; ++jt) \
                _Pragma("unroll") for (int i = 0; i < 16; ++i) { const int kp = ktile * 64 + 32 * jt + crow(i, h); const int dlt = tq - kp; if (dlt > 128 || dlt < -128) S[jt][i] = -1e30f; } \
        } \
          \
        f32x2 ls2 = {0.f, 0.f}; \
        { const LAS bf16_t* Kn = Kt + ((p_) ^ 1) * KB_; bf16x8 kf[8]; \
          _Pragma("unroll") for (int g_ = 0; g_ < 8; ++g_) kf[g_] = *(const LAS bf16x8*)(Kn + (32 * (g_ & 1) + r) * 72 + 16 * (g_ >> 1) + 8 * h); \
          __builtin_amdgcn_sched_barrier(0); \
          _Pragma("unroll") for (int g_ = 0; g_ < 8; ++g_) { \
              Sn[g_ & 1] = MFMA32(kf[g_], Qf[g_ >> 1], g_ < 2 ? negm : Sn[g_ & 1]); \
              _Pragma("unroll") for (int e_ = 0; e_ < 4; e_ += 2) { const int jt = g_ >> 2, i = (g_ & 3) * 4 + e_; \
                  f32x2 t; t[0] = __builtin_amdgcn_exp2f(S[jt][i]); t[1] = __builtin_amdgcn_exp2f(S[jt][i + 1]); ls2 = ls2 + t; S[jt][i] = t[0]; S[jt][i + 1] = t[1]; } \
              __builtin_amdgcn_sched_barrier(0); } } \
        l += ls2[0] + ls2[1]; \
        { const LAS bf16_t* Vc = Vt + (p_) * VB_ + vtr; bf16x8 vf[8]; \
          _Pragma("unroll") for (int f_ = 0; f_ < 8; ++f_) { const LAS bf16_t* vp = Vc + (16 * (f_ >> 1)) * 72 + 32 * (f_ & 1); vf[f_] = cat4(trr(vp), trr(vp + 8 * 72)); }     \
          bf16x8 pf[4]; _Pragma("unroll") for (int f_ = 0; f_ < 4; ++f_) pf[f_] = pack8(S[f_ >> 1], f_ & 1); \
          __builtin_amdgcn_sched_barrier(0); \
          _Pragma("unroll") for (int f_ = 0; f_ < 8; ++f_) accO[f_ & 1] = MFMA32(vf[f_], pf[f_ >> 1], accO[f_ & 1]); } \
        S[0] = Sn[0]; S[1] = Sn[1]; \
        STOREK(it + 2, (p_), kSt); STOREV(it + 1, (p_) ^ 1, vSt); \
        asm volatile("s_waitcnt lgkmcnt(0)\n\ts_barrier" ::: "memory");     \
        } while (0)
    u32x4 kA = {0u, 0u, 0u, 0u}, vA = kA, kB = kA, vB = kA;
    f32x16 S[2];
    { u32x4 k0 = kA, k1 = kA, v0 = kA; LOADK(0, k0); LOADV(0, v0); LOADK(1, k1); LOADK(2, kA); LOADV(1, vA);
      STOREK(0, 0, k0); STOREV(0, 0, v0); STOREK(1, 1, k1); }
    __syncthreads();
    QK(S, 0);
    __syncthreads();
    for (int it2 = 0; it2 < ntiles; it2 += 2) {
        TILE_STEP(it2, 0, kB, vB, kA, vA);
        if (it2 + 1 < ntiles) TILE_STEP(it2 + 1, 1, kA, vA, kB, vB);
    }
#undef TILE_KEY
#undef LOADK
#undef LOADV
#undef STOREK
#undef STOREV
#undef QK
#undef TILE_STEP
    l += shx(l, lane, 32);
    const float il = 1.f / l;
    bf16_t* op = O + (Rb + tq) * D + (mix ? 256 : 0) + head * 64;
#pragma unroll
    for (int nt = 0; nt < 2; ++nt)
#pragma unroll
        for (int g4 = 0; g4 < 4; ++g4) { u32x2 o; o.x = pk2(accO[nt][4 * g4] * il, accO[nt][4 * g4 + 1] * il); o.y = pk2(accO[nt][4 * g4 + 2] * il, accO[nt][4 * g4 + 3] * il);
            *(u32x2*)(op + 32 * nt + 8 * g4 + 4 * h) = o; }
}

DI void gla_out_item(const KP& P, int layer, int b, int tb, LAS unsigned char* lds) {
    const int tid = otid(P.wv), lane = tid & 63, wave = tid >> 6, r = lane & 31, h = lane >> 5;
    const bf16_t* Z = (const bf16_t*)(P.ws + WS_Z); const float* BG = (const float*)(P.ws + WS_BG);
    const bf16_t* SG = (const bf16_t*)(P.ws + WS_UGC); bf16_t* O = (bf16_t*)(P.ws + WS_O);
    const int hd = wave & 3, mh = wave >> 2, t0 = tb * 64, t = 32 * mh + r; const size_t R0 = (size_t)b * TT + t0;
    constexpr int QP = 136, VP = 272, BP = 260;
    LAS bf16_t* Qt = (LAS bf16_t*)lds; LAS bf16_t* Kt = (LAS bf16_t*)(lds + 17408); LAS bf16_t* Vt = (LAS bf16_t*)(lds + 34816); LAS float* Bt = (LAS float*)(lds + 69632);
    { u32x4 qv[2], kv[2], vv[4]; f32x4 bv[8];
#pragma unroll
      for (int i = 0; i < 2; ++i) { const int q = tid + 512 * i, row = q >> 4, ch = q & 15; qv[i] = ldg16(Z + (R0 + row) * ZW + C_QC + ch * 8); kv[i] = ldg16(Z + (R0 + row) * ZW + C_KC + ch * 8); }
#pragma unroll
      for (int i = 0; i < 4; ++i) { const int q = tid + 512 * i, row = q >> 5, ch = q & 31; vv[i] = ldg16(Z + (R0 + row) * ZW + C_VC + ch * 8); }
#pragma unroll
      for (int i = 0; i < 8; ++i) { const int q = tid + 512 * i, row = q >> 6, ch = q & 63; bv[i] = *(const f32x4*)(BG + (R0 + row) * 256 + ch * 4); }
#pragma unroll
      for (int i = 0; i < 2; ++i) { const int q = tid + 512 * i, row = q >> 4, ch = q & 15; *(LAS u32x4*)(Qt + row * QP + ch * 8) = qv[i]; *(LAS u32x4*)(Kt + row * QP + ch * 8) = kv[i]; }
#pragma unroll
      for (int i = 0; i < 4; ++i) { const int q = tid + 512 * i, row = q >> 5, ch = q & 31; *(LAS u32x4*)(Vt + row * VP + ch * 8) = vv[i]; }
#pragma unroll
      for (int i = 0; i < 8; ++i) { const int q = tid + 512 * i, row = q >> 6, ch = q & 63; *(LAS f32x4*)(Bt + row * BP + ch * 4) = bv[i]; } }
    __syncthreads();
    const int vtr = (4 * h + ((lane & 15) >> 2)) * VP + 16 * ((lane >> 4) & 1) + 4 * (lane & 3) + hd * 64;
    f32x16 accO[2]; accO[0] = zero16(); accO[1] = zero16();
#pragma unroll 1
    for (int dir = 0; dir < 2; ++dir) {
        const int c = dir ? (tb < 4 ? 3 - tb : 71 - tb) : tb, chain = (b * 2 + dir) * 4 + hd;
        const bf16_t* sgp = SG + ((size_t)chain * NTB + c) * 2048 + (size_t)r * 32 + 8 * h;
        u32x4 Sf[2][2];
#pragma unroll
        for (int nt = 0; nt < 2; ++nt)
#pragma unroll
            for (int kk = 0; kk < 2; ++kk) Sf[nt][kk] = ldg16(sgp + nt * 1024 + 16 * kk);
        bf16x8 Qf[2];
#pragma unroll
        for (int kk = 0; kk < 2; ++kk) { const int d0 = hd * 32 + 16 * kk + 8 * h; const u32x4 qv = *(const LAS u32x4*)(Qt + t * QP + d0);
            const LAS float* bp = Bt + t * BP + dir * 128 + d0; const f32x4 b0 = *(const LAS f32x4*)bp, b1 = *(const LAS f32x4*)(bp + 4);
            const float sc = 0.17677669529663687f;
            u32x4 o; o.x = pk2(bflo(qv.x) * __expf(b0[0]) * sc, bfhi(qv.x) * __expf(b0[1]) * sc); o.y = pk2(bflo(qv.y) * __expf(b0[2]) * sc, bfhi(qv.y) * __expf(b0[3]) * sc);
            o.z = pk2(bflo(qv.z) * __expf(b1[0]) * sc, bfhi(qv.z) * __expf(b1[1]) * sc); o.w = pk2(bflo(qv.w) * __expf(b1[2]) * sc, bfhi(qv.w) * __expf(b1[3]) * sc);
            Qf[kk] = as_bf8(o); }
#pragma unroll
        for (int jt = 0; jt < 2; ++jt) { f32x16 S = zero16();
#pragma unroll
            for (int kk = 0; kk < 2; ++kk) { const int d0 = hd * 32 + 16 * kk + 8 * h; const u32x4 kv = *(const LAS u32x4*)(Kt + (32 * jt + r) * QP + d0);
                const LAS float* bp = Bt + (32 * jt + r) * BP + dir * 128 + d0; const f32x4 b0 = *(const LAS f32x4*)bp, b1 = *(const LAS f32x4*)(bp + 4);
                u32x4 o; o.x = pk2(bflo(kv.x) * __expf(-b0[0]), bfhi(kv.x) * __expf(-b0[1])); o.y = pk2(bflo(kv.y) * __expf(-b0[2]), bfhi(kv.y) * __expf(-b0[3]));
                o.z = pk2(bflo(kv.z) * __expf(-b1[0]), bfhi(kv.z) * __expf(-b1[1])); o.w = pk2(bflo(kv.w) * __expf(-b1[2]), bfhi(kv.w) * __expf(-b1[3]));
                S = MFMA32(as_bf8(o), Qf[kk], S); }
#pragma unroll
            for (int i = 0; i < 16; ++i) { const int s = 32 * jt + crow(i, h); const bool keep = dir ? (s >= t) : (s <= t); S[i] = keep ? S[i] : 0.f; }
            const bf16x8 Pf0 = pack8(S, 0), Pf1 = pack8(S, 1);
#pragma unroll
            for (int nt = 0; nt < 2; ++nt) { const LAS bf16_t* vp = Vt + vtr + (32 * jt) * VP + 32 * nt;
                accO[nt] = MFMA32(cat4(trr(vp), trr(vp + 8 * VP)), Pf0, accO[nt]);
                accO[nt] = MFMA32(cat4(trr(vp + 16 * VP), trr(vp + 24 * VP)), Pf1, accO[nt]); } }
#pragma unroll
        for (int nt = 0; nt < 2; ++nt)
#pragma unroll
            for (int kk = 0; kk < 2; ++kk) accO[nt] = MFMA32(as_bf8(Sf[nt][kk]), Qf[kk], accO[nt]);
    }
    float ss = 0.f;
#pragma unroll
    for (int nt = 0; nt < 2; ++nt)
#pragma unroll
        for (int i = 0; i < 16; ++i) ss += accO[nt][i] * accO[nt][i];
    ss += shx(ss, lane, 32);
    const float rstd = rsqrtf(ss * (1.f / 64.f) + EPS);
#pragma unroll
    for (int nt = 0; nt < 2; ++nt)
#pragma unroll
        for (int g4 = 0; g4 < 4; ++g4) { const int dv = 32 * nt + 8 * g4 + 4 * h;
            const u32x2 rv = ldg8(Z + (R0 + t) * ZW + C_RC + hd * 64 + dv); const f32x4 gg = *(const f32x4*)(P.g_gla_out + layer * 64 + dv);
            const float rr[4] = {bflo(rv.x), bfhi(rv.x), bflo(rv.y), bfhi(rv.y)}; float y[4];
#pragma unroll
            for (int e = 0; e < 4; ++e) { const float sl = rr[e] / (1.f + __expf(-rr[e])); y[e] = accO[nt][4 * g4 + e] * rstd * gg[e] * sl; }
            u32x2 o; o.x = pk2(y[0], y[1]); o.y = pk2(y[2], y[3]);
            *(u32x2*)(O + (R0 + t) * D + 512 + hd * 64 + dv) = o; }
    __syncthreads();
}

DI void mlstm_out_item(const KP& P, int layer, int b, int tb, LAS unsigned char* lds) {
    const int tid = otid(P.wv), lane = tid & 63, wave = tid >> 6, r = lane & 31, h = lane >> 5;
    const bf16_t* Z = (const bf16_t*)(P.ws + WS_Z); const float* FG = (const float*)(P.ws + WS_FG); const float* IG = (const float*)(P.ws + WS_IG);
    const bf16_t* SG = (const bf16_t*)(P.ws + WS_UGD); const float* NP = (const float*)(P.ws + WS_NGD); bf16_t* O = (bf16_t*)(P.ws + WS_O);
    const int hd = wave & 3, mh = wave >> 2, t0 = tb * 64, t = 32 * mh + r; const size_t R0 = (size_t)b * TT + t0;
    constexpr int QP = 264, VP = 272;
    LAS bf16_t* Qt = (LAS bf16_t*)lds; LAS bf16_t* Kt = (LAS bf16_t*)(lds + 33792); LAS bf16_t* Vt = (LAS bf16_t*)(lds + 67584);
    LAS float* Fs = (LAS float*)(lds + 102400); LAS float* As = Fs + 512;
    { u32x4 qv[4], kv[4], vv[4];
#pragma unroll
      for (int i = 0; i < 4; ++i) { const int q = tid + 512 * i, row = q >> 5, ch = q & 31; const bf16_t* zr = Z + (R0 + row) * ZW + ch * 8;
          qv[i] = ldg16(zr + C_QD); kv[i] = ldg16(zr + C_KD); vv[i] = ldg16(zr + C_VD); }
      f32x4 gv = {0.f, 0.f, 0.f, 0.f};
      if (tid < 128) gv = *(const f32x4*)(FG + R0 * 8 + tid * 4); else if (tid < 256) gv = *(const f32x4*)(IG + R0 * 8 + (tid - 128) * 4);
#pragma unroll
      for (int i = 0; i < 4; ++i) { const int q = tid + 512 * i, row = q >> 5, ch = q & 31;
          *(LAS u32x4*)(Qt + row * QP + ch * 8) = qv[i]; *(LAS u32x4*)(Kt + row * QP + ch * 8) = kv[i]; *(LAS u32x4*)(Vt + row * VP + ch * 8) = vv[i]; }
      if (tid < 256) *(LAS f32x4*)(Fs + tid * 4) = gv; }
    __syncthreads();
    bf16x8 Qf[4];
#pragma unroll
    for (int kk = 0; kk < 4; ++kk) Qf[kk] = *(const LAS bf16x8*)(Qt + t * QP + hd * 64 + 16 * kk + 8 * h);
    f32x16 S[2];
#pragma unroll
    for (int jt = 0; jt < 2; ++jt) { S[jt] = zero16();
#pragma unroll
        for (int kk = 0; kk < 4; ++kk) S[jt] = MFMA32(*(const LAS bf16x8*)(Kt + (32 * jt + r) * QP + hd * 64 + 16 * kk + 8 * h), Qf[kk], S[jt]); }
    const int vtr = (4 * h + ((lane & 15) >> 2)) * VP + 16 * ((lane >> 4) & 1) + 4 * (lane & 3) + hd * 64;
    f32x16 hs[2]; hs[0] = zero16(); hs[1] = zero16();
#pragma unroll 1
    for (int dir = 0; dir < 2; ++dir) {
        const int c = dir ? (tb < 4 ? 3 - tb : 71 - tb) : tb, chain = (b * 2 + dir) * 4 + hd, gi = dir * 4 + hd;
        const bf16_t* sgp = SG + ((size_t)chain * NTB + c) * 4096 + (size_t)r * 64 + 8 * h;
        f32x16 aI[2];
#pragma unroll
        for (int nt = 0; nt < 2; ++nt) { aI[nt] = zero16();
#pragma unroll
            for (int kk = 0; kk < 4; ++kk) aI[nt] = MFMA32(as_bf8(ldg16(sgp + nt * 2048 + 16 * kk)), Qf[kk], aI[nt]); }
        const float* np = NP + ((size_t)chain * NTB + c) * 64;
        float qn = 0.f;
#pragma unroll
        for (int kk = 0; kk < 4; ++kk) { const f32x4 n0 = *(const f32x4*)(np + 16 * kk + 8 * h), n1 = *(const f32x4*)(np + 16 * kk + 8 * h + 4); const u32x4 qv = __builtin_bit_cast(u32x4, Qf[kk]);
            qn += bflo(qv.x) * n0[0] + bfhi(qv.x) * n0[1] + bflo(qv.y) * n0[2] + bfhi(qv.y) * n0[3] + bflo(qv.z) * n1[0] + bfhi(qv.z) * n1[1] + bflo(qv.w) * n1[2] + bfhi(qv.w) * n1[3]; }
        qn += shx(qn, lane, 32);
        const float Ft = Fs[t * 8 + gi];
        float den = 0.f;
        f32x16 aP[2]; aP[0] = zero16(); aP[1] = zero16();
#pragma unroll
        for (int jt = 0; jt < 2; ++jt) { f32x16 Pv;
#pragma unroll
            for (int i = 0; i < 16; ++i) { const int s = 32 * jt + crow(i, h); const bool keep = dir ? (s >= t) : (s <= t);
                const float as = As[s * 8 + gi];
                const float pe = keep ? S[jt][i] * (__expf(Ft + as) * 0.125f) : 0.f; Pv[i] = pe; den += pe; }
            const bf16x8 Pf0 = pack8(Pv, 0), Pf1 = pack8(Pv, 1);
#pragma unroll
            for (int nt = 0; nt < 2; ++nt) { const LAS bf16_t* vp = Vt + vtr + (32 * jt) * VP + 32 * nt;
                aP[nt] = MFMA32(cat4(trr(vp), trr(vp + 8 * VP)), Pf0, aP[nt]);
                aP[nt] = MFMA32(cat4(trr(vp + 16 * VP), trr(vp + 24 * VP)), Pf1, aP[nt]); } }
        den += shx(den, lane, 32);
        const float ef = __expf(Ft), dtot = den + ef * qn, inv = 1.f / fmaxf(fabsf(dtot), 1.f);
#pragma unroll
        for (int nt = 0; nt < 2; ++nt) hs[nt] = hs[nt] + (aP[nt] + aI[nt] * ef) * inv;
    }
    float ss = 0.f;
#pragma unroll
    for (int nt = 0; nt < 2; ++nt)
#pragma unroll
        for (int i = 0; i < 16; ++i) ss += hs[nt][i] * hs[nt][i];
    ss += shx(ss, lane, 32);
    const float rstd = rsqrtf(ss * (1.f / 64.f) + EPS);
#pragma unroll
    for (int nt = 0; nt < 2; ++nt)
#pragma unroll
        for (int g4 = 0; g4 < 4; ++g4) { const int dv = 32 * nt + 8 * g4 + 4 * h;
            const u32x2 ov = ldg8(Z + (R0 + t) * ZW + C_OD + hd * 64 + dv); const f32x4 gg = *(const f32x4*)(P.g_mlstm_out + layer * 64 + dv);
            const float oo[4] = {bflo(ov.x), bfhi(ov.x), bflo(ov.y), bfhi(ov.y)}; float y[4];
#pragma unroll
            for (int e = 0; e < 4; ++e) { const float sg = 1.f / (1.f + __expf(-oo[e])); y[e] = hs[nt][4 * g4 + e] * rstd * gg[e] * sg; }
            u32x2 o; o.x = pk2(y[0], y[1]); o.y = pk2(y[2], y[3]);
            *(u32x2*)(O + (R0 + t) * D + 768 + hd * 64 + dv) = o; }
    __syncthreads();
}

DI void mixer_phase(const KP& P, int layer, LAS unsigned char* lds) {
    const int G = gridDim.x, bx = blockIdx.x;
    const int n_scan = layer == 0 ? NB * NTB : NB * 64;
    for (int r = bx; r < 512; r += G) { const int b = r >> 6, g = (r >> 5) & 1, qb = r & 31; attn_item(P, layer, 0, b, g, CTX + qb * 128, 4, NTB, 0, lds); }
    for (int r = bx; r < 512; r += G) { const int b = r >> 6, g = (r >> 5) & 1, qb = r & 31; const int qt = 4 + 2 * qb; int lo = qt - 2, hi = qt + 4; if (lo < 4) lo = 4; if (hi > NTB) hi = NTB;
        attn_item(P, layer, 1, b, g, CTX + qb * 128, lo, hi, 1, lds); }
    if (layer == 0) for (int r = rot((int)bx, 64, G); r < 64; r += G) { const int mix = r >> 5, b = (r >> 2) & 7, g = (r >> 1) & 1, qb = r & 1; attn_item(P, layer, mix, b, g, qb * 128, 4, 4, 0, lds); }
    for (int rr = rot((int)bx, 128, G); rr < n_scan; rr += G) { int b, tb; if (layer == 0) { b = rr / NTB; tb = rr % NTB; } else { b = rr >> 6; tb = 4 + (rr & 63); } mlstm_out_item(P, layer, b, tb, lds); }
    for (int rr = rot((int)bx, 96, G); rr < n_scan; rr += G) { int b, tb; if (layer == 0) { b = rr / NTB; tb = rr % NTB; } else { b = rr >> 6; tb = 4 + (rr & 63); } gla_out_item(P, layer, b, tb, lds); }
}

#define XB_TMO      128
#define XB_XCNT(j)  (256  + 64 * (j))
#define XB_XSUB(j)  (1280 + 64 * (j))
#define XB_XGEN(j)  (2304 + 64 * (j))
#define XB_TOP      3328
#define XB_TOPGEN   3392
#define XCD_BAR_WORDS 3456
#define XB_SPIN_CAP (1u << 22)
DI unsigned xb_ld(unsigned* p)              { return __hip_atomic_load(p, __ATOMIC_RELAXED, __HIP_MEMORY_SCOPE_AGENT); }
DI unsigned xb_add(unsigned* p, unsigned v) { return __hip_atomic_fetch_add(p, v, __ATOMIC_RELAXED, __HIP_MEMORY_SCOPE_AGENT); }
DI unsigned xb_xcc_id() { return (unsigned)__builtin_amdgcn_s_getreg((3 << 11) | 20) & 0xFu; }
#define XB_SPIN(cond, bar) do { unsigned _sp = 0; while (cond) { __builtin_amdgcn_s_sleep(1); \
    if ((++_sp & 255u) == 0u) { if (xb_ld(&(bar)[XB_TMO])) break; if (_sp > XB_SPIN_CAP) { atomicAdd(&(bar)[XB_TMO], 1u); break; } } } } while (0)
struct XcdBarrier { unsigned* bar; unsigned x; volatile LAS unsigned* st; };
DI XcdBarrier xcd_barrier_post(unsigned* bar, volatile LAS unsigned* st, bool t0) {
    XcdBarrier b; b.bar = bar; b.x = xb_xcc_id(); b.st = st;
    if (t0) (void)xb_add(&bar[XB_XCNT(b.x)], 1u);
    return b;
}
DI void xcd_barrier_complete(unsigned* bar, unsigned x, unsigned& nloc, unsigned& nx) {
    const unsigned G = gridDim.x;
    unsigned sum, cnt, mine, sp = 0u;
    for (;;) {
        sum = 0u; cnt = 0u; mine = 0u;
#pragma unroll
        for (unsigned j = 0; j < 16; ++j) { const unsigned c = xb_ld(&bar[XB_XCNT(j)]); sum += c; cnt += (c > 0u) ? 1u : 0u; mine = (j == x) ? c : mine; }
        if (sum == G) break;
        __builtin_amdgcn_s_sleep(1);
        if ((++sp & 255u) == 0u) { if (xb_ld(&bar[XB_TMO])) break; if (sp > XB_SPIN_CAP) { atomicAdd(&bar[XB_TMO], 1u); break; } }
    }
    nloc = mine > 0u ? mine : 1u; nx = cnt > 0u ? cnt : 1u;
}
DI void xcd_barrier(const XcdBarrier& b, int wv) {
    asm volatile("s_waitcnt vmcnt(0)" ::: "memory");
    __syncthreads();
    if (otid(wv) == 0) {
        unsigned* bar = b.bar;
        __builtin_amdgcn_s_waitcnt(0);
        unsigned nloc = b.st[0], nx = b.st[1];
        if (nloc == 0u) { xcd_barrier_complete(bar, b.x, nloc, nx); b.st[0] = nloc; b.st[1] = nx; }
        const unsigned old = xb_add(&bar[XB_XSUB(b.x)], 1u);
        const unsigned gen = old / nloc;
        if (old + 1u == (gen + 1u) * nloc) {
            __builtin_amdgcn_fence(__ATOMIC_RELEASE, "agent");
            asm volatile("s_waitcnt vmcnt(0)" ::: "memory");
            const unsigned og = xb_add(&bar[XB_TOP], 1u);
            const unsigned tg = og / nx;
            if (og + 1u == (tg + 1u) * nx) xb_add(&bar[XB_TOPGEN], 1u);
            else XB_SPIN(xb_ld(&bar[XB_TOPGEN]) == tg, bar);
            __builtin_amdgcn_fence(__ATOMIC_ACQUIRE, "agent");
            xb_add(&bar[XB_XGEN(b.x)], 1u);
            asm volatile("s_waitcnt vmcnt(0)" ::: "memory");
        } else {
            XB_SPIN(xb_ld(&bar[XB_XGEN(b.x)]) == gen, bar);
            __builtin_amdgcn_fence(__ATOMIC_ACQUIRE, "agent");
            asm volatile("s_waitcnt vmcnt(0)" ::: "memory");
        }
    }
    __syncthreads();
}

__global__ void __launch_bounds__(512, 2) fwd_megakernel(Params Pin) {
    KP P; (Params&)P = Pin; P.wv = __builtin_amdgcn_readfirstlane((int)threadIdx.x >> 6);
    extern __shared__ __attribute__((aligned(16))) unsigned char lds_raw[];
    LAS unsigned char* lds = (LAS unsigned char*)lds_raw;
    cg::grid_group grid = cg::this_grid();
    const int G = gridDim.x, bx = blockIdx.x;
    const float* MOD = (const float*)(P.ws + WS_MOD);
    volatile LAS unsigned* xst = (volatile LAS unsigned*)(lds + LDS_BYTES - 16);
    unsigned* barw = (unsigned*)(P.ws + WS_BAR);
    { const int t = otid(P.wv); if (t == 0) { xst[0] = 0u; xst[1] = 0u; }
      if (bx == 0) for (int i = t; i < XCD_BAR_WORDS; i += 512) barw[i] = 0u; }
    p0_phase(P, lds, 0);
    grid.sync();
    const XcdBarrier xb = xcd_barrier_post(barw, xst, otid(P.wv) == 0);
#define GSYNC() xcd_barrier(xb, P.wv)
    for (int layer = 0; layer < 2; ++layer) {
        const int skip = layer == 1;
        norm_phase(P, layer, 1, 0);
        GSYNC();
        { pg8::Gemm g{(const bf16_t*)(P.ws + WS_H), (const bf16_t*)(P.ws + WS_WIN) + (size_t)layer * ZW * D, D}; pg8::Order S; S.init(ZW / 256, G, bx, 0, D);
          pg8::EpiZ E{(bf16_t*)(P.ws + WS_Z), (float*)(P.ws + WS_GATE)}; pg8::gemm_phase(lds, g, S, E, P.wv); }
        GSYNC();
        prep_phase(P, layer, lds);
        GSYNC();
        chain_phase(P);
        if (layer == 0) p0_phase(P, lds, 1);
        GSYNC();
        mixer_phase(P, layer, lds);
        GSYNC();
        { pg8::Gemm g{(const bf16_t*)(P.ws + WS_O), (const bf16_t*)(P.ws + WS_WOUT) + (size_t)layer * D * D, D}; pg8::Order S; S.init(D / 256, G, bx, 1, D, layer == 0 ? 4 : 0);
          pg8::EpiRes E{P, layer == 0, MOD + (size_t)layer * 9 * 6144 + 2048}; pg8::gemm_phase(lds, g, S, E, P.wv); }
        GSYNC();
        norm_phase(P, layer, 2, skip);
        GSYNC();
        { pg8::Gemm g{(const bf16_t*)(P.ws + WS_H), (const bf16_t*)(P.ws + WS_W1) + (size_t)layer * FF * D, D}; pg8::Order S; S.init(FF / 256, G, bx, skip, D);
          pg8::EpiRelu2 E{(bf16_t*)(P.ws + WS_U1)}; pg8::gemm_phase(lds, g, S, E, P.wv); }
        GSYNC();
        { pg8::Gemm g{(const bf16_t*)(P.ws + WS_U1), (const bf16_t*)(P.ws + WS_W2) + (size_t)layer * D * FF, FF}; pg8::Order S; S.init(D / 256, G, bx, 1, FF, layer == 0 ? 8 : 0);
          pg8::EpiRes E{P, 0, MOD + (size_t)layer * 9 * 6144 + 5120}; pg8::gemm_phase(lds, g, S, E, P.wv); }
        if (layer == 0) GSYNC();
    }
}

extern "C" void kernel_launch(void* const* d_in, const int* in_sizes, int n_in, void* d_out, int out_size, void* d_ws, size_t ws_size, hipStream_t stream) {
    static int grid_blocks = 0;
    if (grid_blocks == 0) {
        if (n_in != 23 || ws_size < WS_END) { fprintf(stderr, "kernel_launch: unexpected n_in %d or ws_size %zu (need %zu)\n", n_in, ws_size, (size_t)WS_END); grid_blocks = -1; return; }
        int dev = 0, cus = 0, per_cu = 0;
        hipGetDevice(&dev);
        hipDeviceGetAttribute(&cus, hipDeviceAttributeMultiprocessorCount, dev);
        hipFuncSetAttribute((const void*)fwd_megakernel, hipFuncAttributeMaxDynamicSharedMemorySize, LDS_BYTES);
        hipOccupancyMaxActiveBlocksPerMultiprocessor(&per_cu, (const void*)fwd_megakernel, 512, LDS_BYTES);
        (void)per_cu;
        grid_blocks = cus;
        (void)hipGetLastError();
    }
    if (grid_blocks < 0) return;
    Params p{};
    const float** pp = (const float**)&p;
    for (int i = 0; i < 23; ++i) pp[i] = (const float*)d_in[i];
    p.out = (float*)d_out; p.ws = (unsigned char*)d_ws;
    void* args[] = {&p};
    hipError_t e = hipLaunchCooperativeKernel((const void*)fwd_megakernel, dim3(grid_blocks), dim3(512), args, LDS_BYTES, stream);
    if (e != hipSuccess) fprintf(stderr, "cooperative launch failed: %s (grid %d)\n", hipGetErrorString(e), grid_blocks);
}
```

```cpp
#include <hip/hip_runtime.h>
#include <hip/hip_cooperative_groups.h>
#include <cstdio>
#include <cstdint>
namespace cg = cooperative_groups;

#define DI __device__ __forceinline__
#define LAS __attribute__((address_space(3)))
typedef unsigned short bf16_t;
typedef short bf16x8 __attribute__((ext_vector_type(8)));
typedef float f32x4 __attribute__((ext_vector_type(4)));
typedef float f32x2 __attribute__((ext_vector_type(2)));
typedef float f32x16 __attribute__((ext_vector_type(16)));
typedef unsigned u32x4 __attribute__((ext_vector_type(4)));
typedef unsigned u32x2 __attribute__((ext_vector_type(2)));
typedef __bf16 bf2_t __attribute__((ext_vector_type(2)));

constexpr int D = 1024, NB = 8, SEQ = 4096, CTX = 256, TT = SEQ + CTX  , MROWS = NB * TT  ;
constexpr int ZW = 3072, FF = 4096, NTB = TT / 64  , INW = 2864;
constexpr float EPS = 1e-6f;
constexpr int C_QA = 0, C_KA = 256, C_VA = 384, C_QB = 512, C_KB = 768, C_VB = 896;
constexpr int C_QC = 1024, C_KC = 1152, C_VC = 1280, C_RC = 1536, C_GC = 1792;
constexpr int C_QD = 1824, C_KD = 2080, C_VD = 2336, C_OD = 2592, C_ID = 2848;
constexpr int LDS_BYTES = 147456;

constexpr size_t al256(size_t x) { return (x + 255) & ~(size_t)255; }
constexpr size_t WS_WIN = 0;
constexpr size_t WS_WOUT = WS_WIN + (size_t)2 * ZW * D * 2;
constexpr size_t WS_W1 = WS_WOUT + (size_t)2 * D * D * 2;
constexpr size_t WS_W2 = WS_W1 + (size_t)2 * FF * D * 2;
constexpr size_t WS_MOD = WS_W2 + (size_t)2 * FF * D * 2;
constexpr size_t WS_XC = WS_MOD + al256((size_t)2 * 9 * 6 * D * 4);
constexpr size_t WS_Z = WS_XC + (size_t)NB * CTX * D * 4;
constexpr size_t WS_O = WS_Z + (size_t)MROWS * ZW * 2;
constexpr size_t WS_H = WS_O + (size_t)MROWS * D * 2;
constexpr size_t WS_U1 = WS_Z;
constexpr size_t WS_SLAB = WS_H + (size_t)MROWS * D * 2;
constexpr size_t WS_BG = WS_H;
constexpr size_t WS_UGD = WS_BG + (size_t)MROWS * 256 * 4;
constexpr size_t WS_UGC = WS_UGD + (size_t)64 * NTB * 4096 * 2;
constexpr size_t WS_ZTC = WS_UGC + (size_t)64 * NTB * 2048 * 2;
constexpr size_t WS_ZTD = WS_ZTC + (size_t)NB * 384 * TT * 2;
constexpr size_t WS_VTAB = WS_ZTD + (size_t)NB * 512 * TT * 2;
constexpr size_t WS_GATE = WS_VTAB + (size_t)NB * 256 * TT * 2;
constexpr size_t WS_FG = WS_GATE + (size_t)MROWS * 48 * 4;
constexpr size_t WS_IG = WS_FG + (size_t)MROWS * 8 * 4;
constexpr size_t WS_DGC = WS_IG + (size_t)MROWS * 8 * 4;
constexpr size_t WS_NGD = WS_DGC + (size_t)64 * NTB * 32 * 4;
constexpr size_t WS_DGD = WS_NGD + (size_t)64 * NTB * 64 * 4;
constexpr size_t WS_BAR = WS_DGD + al256((size_t)64 * NTB * 4);
constexpr size_t WS_END = WS_BAR + 16384;
static_assert(WS_GATE >= WS_H + (size_t)MROWS * D * 2, "GATE must not alias H");
static_assert(WS_END <= (size_t)536870912, "workspace budget");

struct Params {
    const float *x, *c, *ctx, *c_ctx, *w_mod, *b_mod, *g_norm1, *g_norm2, *w_in, *g_q_a, *g_k_a, *g_q_b, *g_k_b, *sink_b,
        *w_gla_gate, *b_gla_gate, *g_gla_out, *b_mlstm_i, *b_mlstm_f, *g_mlstm_out, *w_out, *w_mlp1, *w_mlp2;
    float* out; unsigned char* ws;
};
struct KP : Params { int wv; };

DI unsigned pk2(float lo, float hi) { f32x2 v = {lo, hi}; bf2_t r = __builtin_convertvector(v, bf2_t); return __builtin_bit_cast(unsigned, r); }
DI bf16_t f2bf(float x) { return (bf16_t)(pk2(x, 0.f) & 0xffffu); }
DI float bflo(unsigned u) { return __uint_as_float(u << 16); }
DI float bfhi(unsigned u) { return __uint_as_float(u & 0xffff0000u); }
DI float bf2f(bf16_t h) { return __uint_as_float((unsigned)h << 16); }
DI float logsig(float x) { return fminf(x, 0.f) - __logf(1.f + __expf(-fabsf(x))); }
DI int crow(int i, int h) { return (i & 3) + 8 * (i >> 2) + 4 * h; }
#define MFMA32(a, b, c) __builtin_amdgcn_mfma_f32_32x32x16_bf16((a), (b), (c), 0, 0, 0)
DI bf16x8 as_bf8(u32x4 v) { return __builtin_bit_cast(bf16x8, v); }
DI f32x16 zero16() { f32x16 z;
#pragma unroll
    for (int i = 0; i < 16; ++i) z[i] = 0.f; return z; }
DI bf16x8 pack8(const f32x16& x, int s) {
    u32x4 p; p.x = pk2(x[8 * s], x[8 * s + 1]); p.y = pk2(x[8 * s + 2], x[8 * s + 3]); p.z = pk2(x[8 * s + 4], x[8 * s + 5]); p.w = pk2(x[8 * s + 6], x[8 * s + 7]);
    return as_bf8(p);
}
DI int otid(int wv) { int l; asm volatile("v_mbcnt_lo_u32_b32 %0, -1, 0\n\tv_mbcnt_hi_u32_b32 %0, -1, %0" : "=v"(l)); return wv * 64 + l; }
DI void store_row8(bf16_t* row, const u32x2 (&o)[8], int h) {
#pragma unroll
    for (int k = 0; k < 8; k += 2) { u32x2 a = o[k], b = o[k + 1];
        { auto rr = __builtin_amdgcn_permlane32_swap(a.x, b.x, false, false); a.x = rr[0]; b.x = rr[1]; }
        { auto rr = __builtin_amdgcn_permlane32_swap(a.y, b.y, false, false); a.y = rr[0]; b.y = rr[1]; }
        u32x4 w; w.x = a.x; w.y = a.y; w.z = b.x; w.w = b.y;
        *(u32x4*)(row + 8 * k + 8 * h) = w; }
}
DI int rot(int bx, int k, int G) { int r = bx + k; while (r >= G) r -= G; return r; }
typedef short s16x4 __attribute__((ext_vector_type(4)));
DI s16x4 trr(const LAS bf16_t* p) { return __builtin_amdgcn_ds_read_tr16_b64_v4i16((LAS s16x4*)p); }
DI bf16x8 cat4(s16x4 a, s16x4 b) { return __builtin_shufflevector(a, b, 0, 1, 2, 3, 4, 5, 6, 7); }
DI u32x4 ldg16(const void* p) { return *(const u32x4*)p; }
DI u32x2 ldg8(const void* p) { return *(const u32x2*)p; }

DI const float* xin_tile(const Params& P, int b, int tl  ) { return tl == 0 ? P.ctx + (size_t)b * CTX * D : P.x + ((size_t)b * SEQ + (size_t)(tl - 1) * 256) * D; }
DI float* xst_tile(const Params& P, int b, int tl) { return tl == 0 ? (float*)(P.ws + WS_XC) + (size_t)b * CTX * D : P.out + ((size_t)b * SEQ + (size_t)(tl - 1) * 256) * D; }

namespace pg8 {
constexpr int BM = 256, BK = 64, HALF = 128, HTB = HALF * BK * 2, STAGE_BYTES = 8 * HTB, NXCD = 8, WGM = 8;
DI int lds_byte(int r, int c) { const int st = (r >> 4) * 2 + (c >> 5), rr = r & 15, cc = c & 31, ob = rr * 64 + cc * 2; return st * 1024 + (ob ^ (((ob >> 9) & 1) << 5)); }
DI void stage_rc(int b, int& R, int& C) { const int st = b / 1024, sb = b % 1024, swz = sb ^ (((sb >> 9) & 1) << 5); R = (st >> 1) * 16 + swz / 64; C = (st & 1) * 32 + (swz % 64) / 2; }
DI int perm32(int rho) { const int n = rho >> 4, i = rho & 15; return 8 * (i >> 2) + 4 * n + (i & 3); }
struct Unit { int pm, pn, kofs, nt, split, sl; };
struct Gemm { const bf16_t* A; const bf16_t* Bt; int K; };
struct Order {
    int nM, nN, nwg, G, c, skip, ns, K;
    DI void init(int nN_, int G_, int c_, int skip_, int K_, int ns_ = 0) { skip = skip_; nM = skip_ ? 128 : 136; nN = nN_; nwg = nM * nN; G = G_; c = c_; ns = ns_; K = K_; }
    DI bool next(int i, Unit& u) const {
        const long L = (long)i * G + c;
        u.kofs = 0; u.nt = K / BK; u.split = 0; u.sl = 0;
        if (L >= nwg) { if (ns == 0) return false; const int j = (int)(L - nwg); if (j >= 8 * nN * ns) return false;
            const int sl = j % ns, cu = j / ns; u.pm = (cu / nN) * 17; u.pn = cu % nN; u.nt = K / BK / ns; u.kofs = sl * (K / ns); u.split = 1; u.sl = sl; return true; }
        int wgid = (int)L; { const int q = nwg / NXCD, r = nwg % NXCD, xcd = wgid % NXCD, off = wgid / NXCD; wgid = (xcd < r ? xcd * (q + 1) : r * (q + 1) + (xcd - r) * q) + off; }
        const int nig = WGM * nN, gid = wgid / nig, fm = gid * WGM, gsz = (nM - fm) < WGM ? (nM - fm) : WGM;
        int pm = fm + ((wgid % nig) % gsz); u.pn = (wgid % nig) / gsz;
        u.pm = skip ? pm + pm / 16 + 1 : pm; return true;
    }
};

template <class Epi>
DI void gemm_phase(LAS unsigned char* lds, const Gemm g, const Order& S, const Epi& E, const int wv) {
    const int tid = otid(wv), wid = wv, lane = tid & 63, wr = wid >> 2, wc = wid & 3, fr = lane & 15, fq = lane >> 4;
    const int K = g.K;
    unsigned voffA[2], voffB[2];
#pragma unroll
    for (int i = 0; i < 2; ++i) { int R, C; stage_rc(tid * 16 + i * 8192, R, C); const int Rb = Epi::PERM ? ((R & ~31) + perm32(R & 31)) : R;
        voffA[i] = (unsigned)(R * K + C) * 2u; voffB[i] = (unsigned)(Rb * K + C) * 2u; }
    const size_t kstep = (size_t)(BK * 2);
    const size_t hstep = (size_t)HALF * K * 2;
    const size_t tstep = 2 * hstep;
    const unsigned ldsw = (unsigned)wid * 1024u;
    const int aoff = lds_byte(wr * 64 + fr, fq * 8), boff = lds_byte(wc * 32 + fr, fq * 8);
#define PG8_SA(b, h) (((b) * 2 + (h)) * HTB)
#define PG8_SB(b, h) ((4 + (b) * 2 + (h)) * HTB)
#define PG8_STAGE(bufoff, gbase, voff) do { _Pragma("unroll") for (int _i = 0; _i < 2; ++_i) \
        __builtin_amdgcn_global_load_lds((const unsigned*)((const char*)(gbase) + (voff)[_i]), (LAS unsigned*)(lds + (bufoff) + ldsw + _i * 8192), 16, 0, 0); } while (0)
#define PG8_LDA(dst, b, h) do { _Pragma("unroll") for (int m = 0; m < 4; ++m) _Pragma("unroll") for (int k = 0; k < 2; ++k) dst[m][k] = *(const LAS bf16x8*)(lds + PG8_SA(b, h) + aoff + m * 2048 + k * 1024); } while (0)
#define PG8_LDB(dst, b, h) do { _Pragma("unroll") for (int n = 0; n < 2; ++n) _Pragma("unroll") for (int k = 0; k < 2; ++k) dst[n][k] = *(const LAS bf16x8*)(lds + PG8_SB(b, h) + boff + n * 2048 + k * 1024); } while (0)
#define PG8_MMA(ai, bj, At, Bt) do { __builtin_amdgcn_s_setprio(1); _Pragma("unroll") for (int m = 0; m < 4; ++m) _Pragma("unroll") for (int n = 0; n < 2; ++n) _Pragma("unroll") for (int k = 0; k < 2; ++k) \
        acc[ai][bj][m][n] = __builtin_amdgcn_mfma_f32_16x16x32_bf16(Bt[n][k], At[m][k], acc[ai][bj][m][n], 0, 0, 0); __builtin_amdgcn_s_setprio(0); } while (0)
#define PG8_WAIT_V(n) asm volatile("s_waitcnt vmcnt(" #n ")" ::: "memory")
#define PG8_WAIT_L(n) asm volatile("s_waitcnt lgkmcnt(" #n ")" ::: "memory")
#define PG8_BAR __builtin_amdgcn_s_barrier()
#define PG8_SCHED __builtin_amdgcn_sched_barrier(0)
    Unit cur, nxt; int ui = 0;
    if (!S.next(0, cur)) return;
    f32x4 acc[2][2][4][2];
#pragma unroll
    for (int a = 0; a < 2; ++a)
#pragma unroll
        for (int b = 0; b < 2; ++b)
#pragma unroll
            for (int m = 0; m < 4; ++m)
#pragma unroll
                for (int n = 0; n < 2; ++n) acc[a][b][m][n] = (f32x4){0.f, 0.f, 0.f, 0.f};
    bf16x8 At[4][2], B0[2][2], B1[2][2];
    const char* cA = (const char*)g.A + (size_t)cur.pm * tstep + (size_t)cur.kofs * 2; const char* cB = (const char*)g.Bt + (size_t)cur.pn * tstep + (size_t)cur.kofs * 2;
    PG8_STAGE(PG8_SB(0, 0), cB, voffB); PG8_STAGE(PG8_SB(0, 1), cB + hstep, voffB); PG8_STAGE(PG8_SA(0, 0), cA, voffA); PG8_STAGE(PG8_SA(0, 1), cA + hstep, voffA);
    if (wr == 1) PG8_BAR;
    PG8_WAIT_V(2); PG8_BAR;
    PG8_STAGE(PG8_SB(1, 0), cB + kstep, voffB); PG8_STAGE(PG8_SA(1, 0), cA + kstep, voffA); PG8_STAGE(PG8_SB(1, 1), cB + hstep + kstep, voffB);
    PG8_WAIT_V(6); PG8_BAR;
    for (;;) {
        const bool has_next = S.next(ui + 1, nxt);
        const char* nA = has_next ? (const char*)g.A + (size_t)nxt.pm * tstep + (size_t)nxt.kofs * 2 : cA; const char* nB = has_next ? (const char*)g.Bt + (size_t)nxt.pn * tstep + (size_t)nxt.kofs * 2 : cB;
        const int nt = cur.nt;
        for (int t = 0; t < nt; t += 2) {
            const bool last = (t == nt - 2);
            const char* a1 = cA + (size_t)(t + 1) * kstep;
            const char* a2 = last ? nA : cA + (size_t)(t + 2) * kstep; const char* b2 = last ? nB : cB + (size_t)(t + 2) * kstep;
            const char* a3 = a2 + kstep; const char* b3 = b2 + kstep;
            PG8_LDB(B0, 0, 0); PG8_LDB(B1, 0, 1); PG8_SCHED; PG8_LDA(At, 0, 0); PG8_STAGE(PG8_SA(1, 1), a1 + hstep, voffA);
            PG8_WAIT_V(8); PG8_WAIT_L(0); PG8_BAR; PG8_MMA(0, 0, At, B0); PG8_MMA(0, 1, At, B1); PG8_BAR; PG8_SCHED;
            PG8_LDA(At, 0, 1); PG8_STAGE(PG8_SB(0, 0), b2, voffB); PG8_STAGE(PG8_SB(0, 1), b2 + hstep, voffB); PG8_STAGE(PG8_SA(0, 0), a2, voffA);
            PG8_WAIT_V(8); PG8_WAIT_L(0); PG8_BAR; PG8_MMA(1, 0, At, B0); PG8_MMA(1, 1, At, B1); PG8_BAR; PG8_SCHED;
            PG8_LDB(B0, 1, 0); PG8_LDB(B1, 1, 1); PG8_SCHED; PG8_LDA(At, 1, 0); PG8_STAGE(PG8_SA(0, 1), a2 + hstep, voffA);
            PG8_WAIT_V(8); PG8_WAIT_L(0); PG8_BAR; PG8_MMA(0, 0, At, B0); PG8_MMA(0, 1, At, B1); PG8_BAR; PG8_SCHED;
            PG8_LDA(At, 1, 1); PG8_STAGE(PG8_SB(1, 0), b3, voffB); PG8_STAGE(PG8_SB(1, 1), b3 + hstep, voffB); PG8_STAGE(PG8_SA(1, 0), a3, voffA);
            PG8_WAIT_V(8); PG8_WAIT_L(0); PG8_BAR; PG8_MMA(1, 0, At, B0); PG8_MMA(1, 1, At, B1); PG8_BAR; PG8_SCHED;
        }
        if (wr == 0) PG8_BAR;
        E(acc, cur, wr, wc, fr, fq);
        if (!has_next) break;
#pragma unroll
        for (int a = 0; a < 2; ++a)
#pragma unroll
            for (int b = 0; b < 2; ++b)
#pragma unroll
                for (int m = 0; m < 4; ++m)
#pragma unroll
                    for (int n = 0; n < 2; ++n) acc[a][b][m][n] = (f32x4){0.f, 0.f, 0.f, 0.f};
        cur = nxt; cA = nA; cB = nB; ++ui;
        if (wr == 1) PG8_BAR;
    }
    PG8_WAIT_V(0);
    PG8_BAR;
#undef PG8_SA
#undef PG8_SB
#undef PG8_STAGE
#undef PG8_LDA
#undef PG8_LDB
#undef PG8_MMA
#undef PG8_WAIT_V
#undef PG8_WAIT_L
#undef PG8_BAR
#undef PG8_SCHED
}

struct EpiZ {
    static constexpr bool PERM = true;
    bf16_t* Z; float* GATE;
    DI void operator()(const f32x4 (&acc)[2][2][4][2], const Unit& u, int wr, int wc, int fr, int fq) const {
        const int row0 = u.pm * BM + wr * 64 + fr, col0 = u.pn * BM + wc * 32 + 8 * fq;
#pragma unroll
        for (int ai = 0; ai < 2; ++ai)
#pragma unroll
            for (int m = 0; m < 4; ++m) { const size_t row = (size_t)(row0 + ai * HALF + m * 16);
#pragma unroll
                for (int bj = 0; bj < 2; ++bj) { const int col = col0 + bj * HALF; const f32x4 v0 = acc[ai][bj][m][0], v1 = acc[ai][bj][m][1];
                    u32x4 w; w.x = pk2(v0[0], v0[1]); w.y = pk2(v0[2], v0[3]); w.z = pk2(v1[0], v1[1]); w.w = pk2(v1[2], v1[3]);
                    *(u32x4*)(Z + row * ZW + col) = w;
                    int gc = -1; if (col >= C_GC && col < C_GC + 32) gc = col - C_GC; else if (col >= C_ID && col < C_ID + 16) gc = 32 + col - C_ID;
                    if (gc >= 0) { float* gp = GATE + row * 48 + gc; *(f32x4*)gp = v0; *(f32x4*)(gp + 4) = v1; } } }
    }
};
struct EpiRelu2 {
    static constexpr bool PERM = true;
    bf16_t* U;
    DI void operator()(const f32x4 (&acc)[2][2][4][2], const Unit& u, int wr, int wc, int fr, int fq) const {
        const int row0 = u.pm * BM + wr * 64 + fr, col0 = u.pn * BM + wc * 32 + 8 * fq;
#pragma unroll
        for (int ai = 0; ai < 2; ++ai)
#pragma unroll
            for (int m = 0; m < 4; ++m) { const size_t row = (size_t)(row0 + ai * HALF + m * 16);
#pragma unroll
                for (int bj = 0; bj < 2; ++bj) { const int col = col0 + bj * HALF; f32x4 v0 = acc[ai][bj][m][0], v1 = acc[ai][bj][m][1];
#pragma unroll
                    for (int j = 0; j < 4; ++j) { const float a = fmaxf(v0[j], 0.f), b = fmaxf(v1[j], 0.f); v0[j] = a * a; v1[j] = b * b; }
                    u32x4 w; w.x = pk2(v0[0], v0[1]); w.y = pk2(v0[2], v0[3]); w.z = pk2(v1[0], v1[1]); w.w = pk2(v1[2], v1[3]);
                    *(u32x4*)(U + row * FF + col) = w; } }
    }
};
struct EpiRes {
    static constexpr bool PERM = true;
    Params P; int from_input; const float* ga;
    DI void operator()(const f32x4 (&acc)[2][2][4][2], const Unit& u, int wr, int wc, int fr, int fq) const {
        const int b = u.pm / 17, tl = u.pm % 17;
        const float* rbase = from_input ? xin_tile(P, b, tl) : xst_tile(P, b, tl);
        float* dbase = xst_tile(P, b, tl);
        const float* garow = ga + (size_t)(tl == 0 ? 8 : b) * 6144;
        const int rin = wr * 64 + fr, col0 = u.pn * BM + wc * 32 + 8 * fq;
#pragma unroll
        for (int bj = 0; bj < 2; ++bj) { const int col = col0 + bj * HALF; const f32x4 g0 = *(const f32x4*)(garow + col), g1 = *(const f32x4*)(garow + col + 4);
#pragma unroll
            for (int ai = 0; ai < 2; ++ai)
#pragma unroll
                for (int m = 0; m < 4; ++m) { const size_t off = (size_t)(rin + ai * HALF + m * 16) * D + col;
                    if (u.split) { float* sp = (float*)(P.ws + WS_SLAB) + ((size_t)u.sl * (NB * CTX) + (size_t)b * CTX) * D + off;
                        *(f32x4*)sp = g0 * acc[ai][bj][m][0]; *(f32x4*)(sp + 4) = g1 * acc[ai][bj][m][1]; }
                    else { const f32x4 x0 = *(const f32x4*)(rbase + off), x1 = *(const f32x4*)(rbase + off + 4);
                        *(f32x4*)(dbase + off) = x0 + g0 * acc[ai][bj][m][0]; *(f32x4*)(dbase + off + 4) = x1 + g1 * acc[ai][bj][m][1]; } } }
    }
};
}

DI void transpose_item(const int wv, const float* W, int K, int N, bf16_t* WT, int kb, int nb, LAS float* tile) {
    const int tid = otid(wv), k0 = kb * 64, n0 = nb * 256;
    { const int kk = tid >> 4, c4 = (tid & 15) * 4; f32x4 v[2][4];
#pragma unroll
      for (int i = 0; i < 2; ++i)
#pragma unroll
          for (int j = 0; j < 4; ++j) { const int n = n0 + c4 + 64 * j; v[i][j] = (f32x4){0.f, 0.f, 0.f, 0.f}; if (n < N) v[i][j] = *(const f32x4*)(W + (size_t)(k0 + kk + 32 * i) * N + n); }
#pragma unroll
      for (int i = 0; i < 2; ++i)
#pragma unroll
          for (int j = 0; j < 4; ++j) { LAS float* tp = tile + (kk + 32 * i) * 257 + c4 + 64 * j; tp[0] = v[i][j][0]; tp[1] = v[i][j][1]; tp[2] = v[i][j][2]; tp[3] = v[i][j][3]; } }
    __syncthreads();
    { const int kc = (tid & 7) * 8;
#pragma unroll
      for (int j = 0; j < 4; ++j) { const int n = (tid >> 3) + 64 * j; const LAS float* s = tile + kc * 257 + n;
          u32x4 o; o.x = pk2(s[0], s[257]); o.y = pk2(s[2 * 257], s[3 * 257]); o.z = pk2(s[4 * 257], s[5 * 257]); o.w = pk2(s[6 * 257], s[7 * 257]);
          *(u32x4*)(WT + (size_t)(n0 + n) * K + k0 + kc) = o; } }
    __syncthreads();
}
DI void mod_item(const KP& P, int l, int nc, LAS float* S  , LAS float* red  ) {
    const int tid = otid(P.wv);
    for (int idx = tid; idx < 9 * D; idx += 512) { const int r = idx >> 10, k = idx & 1023; const float v = r < 8 ? P.c[r * D + k] : P.c_ctx[k]; S[idx] = v / (1.f + expf(-v)); }
    __syncthreads();
    const int col = tid % 48, kq = tid / 48, n0 = nc * 48;
    if (kq < 8) {
        float a[9];
#pragma unroll
        for (int r = 0; r < 9; ++r) a[r] = 0.f;
        const float* w = P.w_mod + (size_t)l * D * 6144 + n0 + col;
#pragma unroll 4
        for (int k = kq * 128; k < kq * 128 + 128; ++k) { const float wv = w[(size_t)k * 6144];
#pragma unroll
            for (int r = 0; r < 9; ++r) a[r] += S[r * D + k] * wv; }
#pragma unroll
        for (int r = 0; r < 9; ++r) red[(kq * 9 + r) * 48 + col] = a[r];
    }
    __syncthreads();
    float* MOD = (float*)(P.ws + WS_MOD);
    if (tid < 9 * 48) { const int r = tid / 48, cc = tid % 48; float s = P.b_mod[l * 6144 + n0 + cc];
#pragma unroll
        for (int q = 0; q < 8; ++q) s += red[(q * 9 + r) * 48 + cc];
        MOD[((size_t)l * 9 + r) * 6144 + n0 + cc] = s; }
    __syncthreads();
}
DI void p0_phase(const KP& P, LAS unsigned char* lds, const int lsel  ) {
    const int G = gridDim.x;
    LAS float* lf = (LAS float*)lds;
    if (lsel == 0) for (int it = blockIdx.x; it < 256; it += G) mod_item(P, it >> 7, it & 127, lf, lf + 9 * D);
    if (lsel == 0) { float* XC = (float*)(P.ws + WS_XC); const int gt = blockIdx.x * 512 + otid(P.wv);
      for (int i = gt; i < NB * CTX * D / 4; i += G * 512) ((f32x4*)XC)[i] = ((const f32x4*)P.ctx)[i]; }
    constexpr int I_IN = 16 * 12, I_OUT = 16 * 4, I_1 = 16 * 16, I_2 = 64 * 4, PER = I_IN + I_OUT + I_1 + I_2;
    for (int it = rot((int)blockIdx.x, 160, G); it < PER; it += G) {
        const int l = lsel; int r = it;
        if (r < I_IN) { transpose_item(P.wv, P.w_in + (size_t)l * D * INW, D, INW, (bf16_t*)(P.ws + WS_WIN) + (size_t)l * ZW * D, r / 12, r % 12, lf); continue; } r -= I_IN;
        if (r < I_OUT) { transpose_item(P.wv, P.w_out + (size_t)l * D * D, D, D, (bf16_t*)(P.ws + WS_WOUT) + (size_t)l * D * D, r / 4, r % 4, lf); continue; } r -= I_OUT;
        if (r < I_1) { transpose_item(P.wv, P.w_mlp1 + (size_t)l * D * FF, D, FF, (bf16_t*)(P.ws + WS_W1) + (size_t)l * FF * D, r / 16, r % 16, lf); continue; } r -= I_1;
        transpose_item(P.wv, P.w_mlp2 + (size_t)l * FF * D, FF, D, (bf16_t*)(P.ws + WS_W2) + (size_t)l * D * FF, r / 4, r % 4, lf);
    }
}

DI void norm_phase(const KP& P, int layer, int which  , int skip_ctx) {
    const int tid = otid(P.wv), lane = tid & 63, wave = tid >> 6;
    const int gw = blockIdx.x * 8 + wave, NGW = gridDim.x * 8;
    const float* MOD = (const float*)(P.ws + WS_MOD);
    bf16_t* H = (bf16_t*)(P.ws + WS_H);
    const float* g = (which == 1 ? P.g_norm1 : P.g_norm2) + layer * D;
    const int nslab = (layer == 0 && which == 2) ? 4 : (layer == 1 && which == 1) ? 8 : 0;
    for (int R = gw; R < MROWS; R += NGW) {
        const int b = R / TT, t = R % TT;
        if (skip_ctx && t < CTX) continue;
        const int tl = t < CTX ? 0 : 1 + ((t - CTX) >> 8), rin = t < CTX ? t : ((t - CTX) & 255);
        const float* src = ((which == 1 && layer == 0) ? xin_tile(P, b, tl) : xst_tile(P, b, tl)) + (size_t)rin * D;
        const float* mrow = MOD + ((size_t)layer * 9 + (t < CTX ? 8 : b)) * 6144 + (which == 1 ? 0 : 3072);
        f32x4 v[4]; float ss = 0.f;
#pragma unroll
        for (int j = 0; j < 4; ++j) v[j] = *(const f32x4*)(src + 8 * lane + 512 * (j >> 1) + 4 * (j & 1));
        if (nslab && t < CTX) { const float* sl = (const float*)(P.ws + WS_SLAB) + ((size_t)b * CTX + t) * D + 8 * lane;
            for (int s = 0; s < nslab; ++s)
#pragma unroll
                for (int j = 0; j < 4; ++j) v[j] = v[j] + *(const f32x4*)(sl + (size_t)s * (NB * CTX) * D + 512 * (j >> 1) + 4 * (j & 1));
            if (which == 2) { float* dst = xst_tile(P, b, 0) + (size_t)rin * D + 8 * lane;
#pragma unroll
                for (int j = 0; j < 4; ++j) *(f32x4*)(dst + 512 * (j >> 1) + 4 * (j & 1)) = v[j]; } }
#pragma unroll
        for (int j = 0; j < 4; ++j) { ss += v[j][0] * v[j][0] + v[j][1] * v[j][1] + v[j][2] * v[j][2] + v[j][3] * v[j][3]; }
#pragma unroll
        for (int o = 1; o < 64; o <<= 1) ss += __shfl_xor(ss, o);
        const float rstd = rsqrtf(ss * (1.f / D) + EPS);
#pragma unroll
        for (int jj = 0; jj < 2; ++jj) { u32x4 o;
#pragma unroll
            for (int hh = 0; hh < 2; ++hh) { const int j = 2 * jj + hh, col = 8 * lane + 512 * jj + 4 * hh;
                const f32x4 gg = *(const f32x4*)(g + col), sh = *(const f32x4*)(mrow + col), sc = *(const f32x4*)(mrow + 1024 + col);
                f32x4 y;
#pragma unroll
                for (int e = 0; e < 4; ++e) y[e] = v[j][e] * rstd * gg[e] * (1.f + sc[e]) + sh[e];
                if (hh == 0) { o.x = pk2(y[0], y[1]); o.y = pk2(y[2], y[3]); } else { o.z = pk2(y[0], y[1]); o.w = pk2(y[2], y[3]); } }
            *(u32x4*)(H + (size_t)R * D + 8 * lane + 512 * jj) = o; }
    }
}

DI void attn_prep_item(const KP& P, int layer, int b, int tb, LAS unsigned char* lds) {
    const int tid = otid(P.wv), lane = tid & 63, wave = tid >> 6;
    bf16_t* Z = (bf16_t*)(P.ws + WS_Z);
    const int t0 = tb * 64; const size_t R0 = (size_t)b * TT + t0;
    { const int p = lane & 31, hv = lane >> 5, fi = p & 15;
      const float inv = exp2f(-(float)fi * (13.287712379549449f / 16.f));
      float gk_a[2], gk_b[2];
#pragma unroll
      for (int e = 0; e < 2; ++e) { gk_a[e] = P.g_k_a[layer * 64 + 2 * p + e]; gk_b[e] = P.g_k_b[layer * 64 + 2 * p + e]; }
      unsigned uu[8][2];
#pragma unroll
      for (int ti = 0; ti < 8; ++ti)
#pragma unroll
          for (int i = 0; i < 2; ++i) { const int cb = (i ? C_KB : C_KA) + 64 * hv; uu[ti][i] = *(const unsigned*)(Z + (R0 + wave * 8 + ti) * ZW + cb + 2 * p); }
#pragma unroll
      for (int ti = 0; ti < 8; ++ti) { const int t = t0 + wave * 8 + ti; bf16_t* zr = Z + (R0 + wave * 8 + ti) * ZW;
          float cs = 1.f, sn = 0.f;
          if (t >= CTX) { const int tl = t - CTX; const float pos = (float)(p < 16 ? (tl >> 6) : (tl & 63)); const float ang = pos * inv; cs = __cosf(ang); sn = __sinf(ang); }
#pragma unroll
          for (int i = 0; i < 2; ++i) { const int cb = (i ? C_KB : C_KA) + 64 * hv;
              const float g0 = i ? gk_b[0] : gk_a[0], g1 = i ? gk_b[1] : gk_a[1];
              const unsigned u = uu[ti][i]; const float x1 = bflo(u), x2 = bfhi(u);
              float ss = x1 * x1 + x2 * x2;
#pragma unroll
              for (int o = 1; o < 32; o <<= 1) ss += __shfl_xor(ss, o);
              const float rstd = rsqrtf(ss * (1.f / 64.f) + EPS);
              const float y1 = x1 * rstd * g0, y2 = x2 * rstd * g1;
              *(unsigned*)(zr + cb + 2 * p) = pk2(y1 * cs - y2 * sn, y1 * sn + y2 * cs); } } }
}

DI void gla_prep_item(const KP& P, int layer, int b, int tb, LAS unsigned char* lds) {
    const int tid = otid(P.wv), lane = tid & 63, wave = tid >> 6, r = lane & 31, h = lane >> 5;
    const bf16_t* Z = (const bf16_t*)(P.ws + WS_Z); const float* GATE = (const float*)(P.ws + WS_GATE);
    const int t0 = tb * 64; const size_t R0 = (size_t)b * TT + t0;
    constexpr int KP_ = 144, VP = 272;
    LAS bf16_t* Kt = (LAS bf16_t*)lds;
    LAS bf16_t* Vt = (LAS bf16_t*)(lds + 18432);
    LAS float* Bc = (LAS float*)(lds + 53248);
    LAS float* Gt = (LAS float*)(lds + 118784);
    { u32x4 kv[2], vv[4];
#pragma unroll
      for (int i = 0; i < 2; ++i) { const int q = tid + 512 * i, row = q >> 4, ch = q & 15; kv[i] = ldg16(Z + (R0 + row) * ZW + C_KC + ch * 8); }
#pragma unroll
      for (int i = 0; i < 4; ++i) { const int q = tid + 512 * i, row = q >> 5, ch = q & 31; vv[i] = ldg16(Z + (R0 + row) * ZW + C_VC + ch * 8); }
      const int tok = tid >> 3, c4 = (tid & 7) * 4; const f32x4 gv = *(const f32x4*)(GATE + (R0 + tok) * 48 + c4);
#pragma unroll
      for (int i = 0; i < 2; ++i) { const int q = tid + 512 * i, row = q >> 4, ch = q & 15; *(LAS u32x4*)(Kt + row * KP_ + ch * 8) = kv[i]; }
#pragma unroll
      for (int i = 0; i < 4; ++i) { const int q = tid + 512 * i, row = q >> 5, ch = q & 31; *(LAS u32x4*)(Vt + row * VP + ch * 8) = vv[i]; }
      *(LAS f32x4*)(Gt + tok * 32 + c4) = gv; }
    __syncthreads();
    float* BG = (float*)(P.ws + WS_BG);
    { const int dc = tid & 255, dir = dc >> 7, ch = dc & 127;
      float w[16];
#pragma unroll
      for (int k = 0; k < 16; ++k) w[k] = P.w_gla_gate[(((size_t)layer * 2 + dir) * 16 + k) * 128 + ch];
      const float bias = P.b_gla_gate[(layer * 2 + dir) * 128 + ch];
      for (int i = 0; i < 32; ++i) { const int t = (tid >> 8) + 2 * i; float pre = bias;
#pragma unroll
          for (int k = 0; k < 16; ++k) pre += Gt[t * 32 + dir * 16 + k] * w[k];
          Bc[(dir * 64 + t) * 128 + ch] = logsig(pre) * (1.f / 16.f); } }
    __syncthreads();
    if (tid < 256) { const int dir = tid >> 7, ch = tid & 127; float run = 0.f;
        for (int step = 0; step < 64; ++step) { const int t = dir ? 63 - step : step;
            run += Bc[(dir * 64 + t) * 128 + ch]; Bc[(dir * 64 + t) * 128 + ch] = run; BG[(R0 + t) * 256 + dir * 128 + ch] = run; } }
    __syncthreads();
    { const int hd = wave & 3, dir = wave >> 2;
      const float be = Bc[(dir * 64 + (dir ? 0 : 63)) * 128 + hd * 32 + r];
      const int qq = (lane & 15) >> 2, pp = lane & 3, blk = (lane >> 4) & 1;
      const int vtrK = (8 * h + qq) * KP_ + 16 * blk + 4 * pp + hd * 32, vtrV = (8 * h + qq) * VP + 16 * blk + 4 * pp + hd * 64;
      f32x16 acc[2]; acc[0] = zero16(); acc[1] = zero16();
#pragma unroll
      for (int kk = 0; kk < 4; ++kk) { const int s0 = 16 * kk + 8 * h;
          const s16x4 klo = trr(Kt + vtrK + 16 * kk * KP_), khi = trr(Kt + vtrK + (16 * kk + 4) * KP_);
          float kw[8];
#pragma unroll
          for (int j = 0; j < 4; ++j) { kw[j] = bf2f((bf16_t)klo[j]) * __expf(be - Bc[(dir * 64 + s0 + j) * 128 + hd * 32 + r]); kw[4 + j] = bf2f((bf16_t)khi[j]) * __expf(be - Bc[(dir * 64 + s0 + 4 + j) * 128 + hd * 32 + r]); }
          u32x4 bp; bp.x = pk2(kw[0], kw[1]); bp.y = pk2(kw[2], kw[3]); bp.z = pk2(kw[4], kw[5]); bp.w = pk2(kw[6], kw[7]);
#pragma unroll
          for (int mt = 0; mt < 2; ++mt) { const LAS bf16_t* vp = Vt + vtrV + 16 * kk * VP + 32 * mt; acc[mt] = MFMA32(cat4(trr(vp), trr(vp + 4 * VP)), as_bf8(bp), acc[mt]); } }
      const int chain = (b * 2 + dir) * 4 + hd, c = dir ? (tb < 4 ? 3 - tb : 71 - tb) : tb;
      bf16_t* UG = (bf16_t*)(P.ws + WS_UGC) + ((size_t)chain * NTB + c) * 2048;
#pragma unroll
      for (int mt = 0; mt < 2; ++mt)
#pragma unroll
          for (int i = 0; i < 16; ++i) UG[(32 * mt + crow(i, h)) * 32 + r] = f2bf(acc[mt][i]);
      if (h == 0) ((float*)(P.ws + WS_DGC))[((size_t)chain * NTB + c) * 32 + r] = __expf(be); }
    __syncthreads();
}

DI void mlstm_prep_item(const KP& P, int layer, int b, int tb, LAS unsigned char* lds) {
    const int tid = otid(P.wv), lane = tid & 63, wave = tid >> 6, r = lane & 31, h = lane >> 5;
    const bf16_t* Z = (const bf16_t*)(P.ws + WS_Z); const float* GATE = (const float*)(P.ws + WS_GATE);
    const int t0 = tb * 64; const size_t R0 = (size_t)b * TT + t0;
    constexpr int VP = 272;
    LAS bf16_t* Kt = (LAS bf16_t*)lds;
    LAS bf16_t* Vt = (LAS bf16_t*)(lds + 34816);
    LAS float* Fl = (LAS float*)(lds + 69632);
    LAS float* Il = Fl + 512;
    LAS float* Gt = Il + 512;
    { u32x4 kv[4], vv[4];
#pragma unroll
      for (int i = 0; i < 4; ++i) { const int q = tid + 512 * i, row = q >> 5, ch = q & 31; const bf16_t* zr = Z + (R0 + row) * ZW + ch * 8; kv[i] = ldg16(zr + C_KD); vv[i] = ldg16(zr + C_VD); }
      f32x4 gv = {0.f, 0.f, 0.f, 0.f};
      if (tid < 256) { const int tok = tid >> 2, c4 = (tid & 3) * 4; gv = *(const f32x4*)(GATE + (R0 + tok) * 48 + 32 + c4); }
#pragma unroll
      for (int i = 0; i < 4; ++i) { const int q = tid + 512 * i, row = q >> 5, ch = q & 31; *(LAS u32x4*)(Kt + row * VP + ch * 8) = kv[i]; *(LAS u32x4*)(Vt + row * VP + ch * 8) = vv[i]; }
      if (tid < 256) { const int tok = tid >> 2, c4 = (tid & 3) * 4; *(LAS f32x4*)(Gt + tok * 16 + c4) = gv; } }
    __syncthreads();
    { const int t = tid >> 3, gi = tid & 7;
      Il[gi * 64 + t] = Gt[t * 16 + gi] + P.b_mlstm_i[layer * 8 + gi]; Fl[gi * 64 + t] = logsig(Gt[t * 16 + 8 + gi] + P.b_mlstm_f[layer * 8 + gi]); }
    __syncthreads();
    if (tid < 8) { const int dir = tid >> 2;
        float* FG = (float*)(P.ws + WS_FG); float* IG = (float*)(P.ws + WS_IG);
        float run = 0.f;
        for (int step = 0; step < 64; ++step) { const int t = dir ? 63 - step : step;
            run += Fl[tid * 64 + t]; Fl[tid * 64 + t] = run; FG[(R0 + t) * 8 + tid] = run; IG[(R0 + t) * 8 + tid] = Il[tid * 64 + t] - run; } }
    __syncthreads();
    { const int hd = wave & 3, dir = wave >> 2, gi = dir * 4 + hd;
      const float Fend = Fl[gi * 64 + (dir ? 0 : 63)];
      const int vtr = (8 * h + ((lane & 15) >> 2)) * VP + 16 * ((lane >> 4) & 1) + 4 * (lane & 3) + hd * 64;
      f32x16 acc[2][2]; acc[0][0] = zero16(); acc[0][1] = zero16(); acc[1][0] = zero16(); acc[1][1] = zero16();
      float nsum[2] = {0.f, 0.f};
#pragma unroll
      for (int kk = 0; kk < 4; ++kk) { const int s0 = 16 * kk + 8 * h;
          float wts[8];
#pragma unroll
          for (int j = 0; j < 8; ++j) wts[j] = __expf(Fend - Fl[gi * 64 + s0 + j] + Il[gi * 64 + s0 + j]) * 0.125f;
          u32x4 bp[2];
#pragma unroll
          for (int nt = 0; nt < 2; ++nt) { const LAS bf16_t* kp = Kt + vtr + 16 * kk * VP + 32 * nt; const s16x4 klo = trr(kp), khi = trr(kp + 4 * VP);
              float kw[8];
#pragma unroll
              for (int j = 0; j < 4; ++j) { kw[j] = bf2f((bf16_t)klo[j]) * wts[j]; kw[4 + j] = bf2f((bf16_t)khi[j]) * wts[4 + j]; nsum[nt] += kw[j] + kw[4 + j]; }
              bp[nt].x = pk2(kw[0], kw[1]); bp[nt].y = pk2(kw[2], kw[3]); bp[nt].z = pk2(kw[4], kw[5]); bp[nt].w = pk2(kw[6], kw[7]); }
#pragma unroll
          for (int mt = 0; mt < 2; ++mt) { const LAS bf16_t* vp = Vt + vtr + 16 * kk * VP + 32 * mt; const bf16x8 av = cat4(trr(vp), trr(vp + 4 * VP));
#pragma unroll
              for (int nt = 0; nt < 2; ++nt) acc[mt][nt] = MFMA32(av, as_bf8(bp[nt]), acc[mt][nt]); } }
      const int chain = (b * 2 + dir) * 4 + hd, c = dir ? (tb < 4 ? 3 - tb : 71 - tb) : tb;
      bf16_t* UG = (bf16_t*)(P.ws + WS_UGD) + ((size_t)chain * NTB + c) * 4096;
#pragma unroll
      for (int mt = 0; mt < 2; ++mt)
#pragma unroll
          for (int nt = 0; nt < 2; ++nt)
#pragma unroll
              for (int i = 0; i < 16; ++i) UG[(32 * mt + crow(i, h)) * 64 + 32 * nt + r] = f2bf(acc[mt][nt][i]);
#pragma unroll
      for (int nt = 0; nt < 2; ++nt) { nsum[nt] += __shfl_xor(nsum[nt], 32); if (h == 0) ((float*)(P.ws + WS_NGD))[((size_t)chain * NTB + c) * 64 + 32 * nt + r] = nsum[nt]; }
      if (lane == 0) ((float*)(P.ws + WS_DGD))[(size_t)chain * NTB + c] = __expf(Fend); }
    __syncthreads();
}

DI void prep_phase(const KP& P, int layer, LAS unsigned char* lds) {
    const int G = gridDim.x; constexpr int NBT = NB * NTB;
    for (int it = blockIdx.x; it < NBT; it += G) mlstm_prep_item(P, layer, it / NTB, it % NTB, lds);
    for (int it = rot((int)blockIdx.x, 224, G); it < NBT; it += G) gla_prep_item(P, layer, it / NTB, it % NTB, lds);
    for (int it = rot((int)blockIdx.x, 192, G); it < NBT; it += G) attn_prep_item(P, layer, it / NTB, it % NTB, lds);
}

DI void chain_phase(const KP& P) {
    const int gt = blockIdx.x * 512 + otid(P.wv), GS = gridDim.x * 512;
    bf16_t* UC = (bf16_t*)(P.ws + WS_UGC); const float* DC = (const float*)(P.ws + WS_DGC);
    bf16_t* UD = (bf16_t*)(P.ws + WS_UGD); const float* DD = (const float*)(P.ws + WS_DGD); float* NG = (float*)(P.ws + WS_NGD);
    for (int e = gt; e < 64 * 2048; e += GS) { const int chain = e >> 11, idx = e & 2047, d = idx & 31; float s = 0.f;
#pragma unroll 1
        for (int c0 = 0; c0 < NTB; c0 += 17) { float u[17], dc[17];
#pragma unroll
            for (int j = 0; j < 17; ++j) { const size_t p = (size_t)chain * NTB + c0 + j; u[j] = bf2f(UC[p * 2048 + idx]); dc[j] = DC[p * 32 + d]; }
#pragma unroll
            for (int j = 0; j < 17; ++j) { const size_t p = (size_t)chain * NTB + c0 + j; UC[p * 2048 + idx] = f2bf(s); s = dc[j] * s + u[j]; } } }
    for (int e = gt; e < 64 * 4096; e += GS) { const int chain = e >> 12, idx = e & 4095; float s = 0.f;
#pragma unroll 1
        for (int c0 = 0; c0 < NTB; c0 += 17) { float u[17], dc[17];
#pragma unroll
            for (int j = 0; j < 17; ++j) { const size_t p = (size_t)chain * NTB + c0 + j; u[j] = bf2f(UD[p * 4096 + idx]); dc[j] = DD[p]; }
#pragma unroll
            for (int j = 0; j < 17; ++j) { const size_t p = (size_t)chain * NTB + c0 + j; UD[p * 4096 + idx] = f2bf(s); s = dc[j] * s + u[j]; } } }
    for (int e = gt; e < 64 * 64; e += GS) { const int chain = e >> 6, idx = e & 63; float s = 0.f;
#pragma unroll 1
        for (int c0 = 0; c0 < NTB; c0 += 17) { float u[17], dc[17];
#pragma unroll
            for (int j = 0; j < 17; ++j) { const size_t p = (size_t)chain * NTB + c0 + j; u[j] = NG[p * 64 + idx]; dc[j] = DD[p]; }
#pragma unroll
            for (int j = 0; j < 17; ++j) { const size_t p = (size_t)chain * NTB + c0 + j; NG[p * 64 + idx] = s; s = dc[j] * s + u[j]; } } }
}

DI void attn_item(const KP& P, int layer, int mix  , int b, int g, int q0  , int lo, int hi, int window, LAS unsigned char* lds) {
    const int tid = otid(P.wv), lane = tid & 63, wave = tid >> 6, r = lane & 31, h = lane >> 5;
    const bf16_t* Z = (const bf16_t*)(P.ws + WS_Z); bf16_t* O = (bf16_t*)(P.ws + WS_O);
    const int head = g * 2 + (wave >> 2), tq = q0 + 32 * (wave & 3) + r;
    const int qcol = mix ? C_QB : C_QA, kcol = (mix ? C_KB : C_KA) + g * 64;
    const size_t Rb = (size_t)b * TT;
    LAS bf16_t* Kt = (LAS bf16_t*)lds;
    LAS bf16_t* Vt = (LAS bf16_t*)(lds + 18432);
    constexpr int KB_ = 64 * 72, VB_ = 64 * 72;
    const int vtr = (4 * h + ((lane & 15) >> 2)) * 72 + 16 * ((lane >> 4) & 1) + 4 * (lane & 3);
    bf16x8 Qf[4];
    const float QS = 0.18033688011112042f;
    { u32x4 qr[4]; float ss = 0.f;
#pragma unroll
      for (int kk = 0; kk < 4; ++kk) { qr[kk] = ldg16(Z + (Rb + tq) * ZW + qcol + head * 64 + 16 * kk + 8 * h);
#pragma unroll
          for (int j = 0; j < 4; ++j) { const float x1 = bflo(qr[kk][j]), x2 = bfhi(qr[kk][j]); ss += x1 * x1 + x2 * x2; } }
      ss += __shfl_xor(ss, 32);
      const float rstd = rsqrtf(ss * (1.f / 64.f) + EPS);
      const float* gq = (mix ? P.g_q_b : P.g_q_a) + layer * 64;
      const bool rope = tq >= CTX; const int tl = tq - CTX; const float prow = (float)(tl >> 6), pcol = (float)(tl & 63);
#pragma unroll
      for (int kk = 0; kk < 4; ++kk) { const f32x4 g0 = *(const f32x4*)(gq + 16 * kk + 8 * h), g1 = *(const f32x4*)(gq + 16 * kk + 8 * h + 4);
          const float gg[8] = {g0[0], g0[1], g0[2], g0[3], g1[0], g1[1], g1[2], g1[3]};
          u32x4 o;
#pragma unroll
          for (int j = 0; j < 4; ++j) { const int fi = 8 * (kk & 1) + 4 * h + j;
              float cs = 1.f, sn = 0.f;
              if (rope) { const float ang = (kk < 2 ? prow : pcol) * exp2f(-(float)fi * (13.287712379549449f / 16.f)); cs = __cosf(ang); sn = __sinf(ang); }
              const float y1 = bflo(qr[kk][j]) * rstd * gg[2 * j] * QS, y2 = bfhi(qr[kk][j]) * rstd * gg[2 * j + 1] * QS;
              o[j] = pk2(y1 * cs - y2 * sn, y1 * sn + y2 * cs); }
          Qf[kk] = as_bf8(o); } }
    float m, l = 0.f;
    { float gq = fabsf(((mix ? P.g_q_b : P.g_q_a) + layer * 64)[lane]), gk = fabsf(((mix ? P.g_k_b : P.g_k_a) + layer * 64)[lane]);
#pragma unroll
      for (int o = 1; o < 64; o <<= 1) { gq = fmaxf(gq, __shfl_xor(gq, o)); gk = fmaxf(gk, __shfl_xor(gk, o)); }
      m = fminf(8.f * 1.02f * gq * gk * 1.4426950408889634f, 40.f); }
    if (mix) { const float sk = P.sink_b[layer * 4 + head] * 1.4426950408889634f; m = fmaxf(m, sk); l = h ? 0.f : __builtin_amdgcn_exp2f(sk - m); }
    f32x16 accO[2]; accO[0] = zero16(); accO[1] = zero16();
    f32x16 negm;
#pragma unroll
    for (int i = 0; i < 16; ++i) negm[i] = -m;
    const int ntiles = 4 + (hi - lo);
    const int srow = tid >> 3, sch = (tid & 7) * 8;
    const bf16_t* kbase = Z + (Rb + srow) * ZW + kcol + sch;
    const bf16_t* vbase = Z + (Rb + srow) * ZW + (mix ? C_VB : C_VA) + g * 64 + sch;
#define TILE_KEY(i) (((i) < 4 ? (i) : lo + (i) - 4) * 64)
#define LOADK(i, kr) do { if ((i) < ntiles) kr = ldg16(kbase + (size_t)TILE_KEY(i) * ZW); } while (0)
#define LOADV(i, vr) do { if ((i) < ntiles) vr = ldg16(vbase + (size_t)TILE_KEY(i) * ZW); } while (0)
#define STOREK(i, buf, kr) do { if ((i) < ntiles) *(LAS u32x4*)(Kt + (buf) * KB_ + srow * 72 + sch) = kr; } while (0)
#define STOREV(i, buf, vr) do { if ((i) < ntiles) *(LAS u32x4*)(Vt + (buf) * VB_ + srow * 72 + sch) = vr; } while (0)
#define QK(dst, buf) do { const LAS bf16_t* Kc = Kt + (buf) * KB_; \
        _Pragma("unroll") for (int jt = 0; jt < 2; ++jt) { dst[jt] = negm; \
            _Pragma("unroll") for (int kk = 0; kk < 4; ++kk) { const bf16x8 a = *(const LAS bf16x8*)(Kc + (32 * jt + r) * 72 + 16 * kk + 8 * h); dst[jt] = MFMA32(a, Qf[kk], dst[jt]); } } } while (0)
#define TILE_STEP(it_, p_, kLd, vLd, kSt, vSt) do { \
        const int it = (it_); \
        LOADK(it + 3, kLd); LOADV(it + 2, vLd); \
        f32x16 Sn[2]; \
        if (window && it >= 4) { const int ktile = lo + it - 4; \
            _Pragma("unroll") for (int jt = 0; jt < 2; ++jt) \
                _Pragma("unroll") for (int i = 0; i < 16; ++i) { const int kp = ktile * 64 + 32 * jt + crow(i, h); const int dlt = tq - kp; if (dlt > 128 || dlt < -128) S[jt][i] = -1e30f; } \
        } \
          \
        f32x2 ls2 = {0.f, 0.f}; \
        { const LAS bf16_t* Kn = Kt + ((p_) ^ 1) * KB_; bf16x8 kf[8]; \
          _Pragma("unroll") for (int g_ = 0; g_ < 8; ++g_) kf[g_] = *(const LAS bf16x8*)(Kn + (32 * (g_ & 1) + r) * 72 + 16 * (g_ >> 1) + 8 * h); \
          __builtin_amdgcn_sched_barrier(0); \
          _Pragma("unroll") for (int g_ = 0; g_ < 8; ++g_) { \
              Sn[g_ & 1] = MFMA32(kf[g_], Qf[g_ >> 1], g_ < 2 ? negm : Sn[g_ & 1]); \
              _Pragma("unroll") for (int e_ = 0; e_ < 4; e_ += 2) { const int jt = g_ >> 2, i = (g_ & 3) * 4 + e_; \
                  f32x2 t; t[0] = __builtin_amdgcn_exp2f(S[jt][i]); t[1] = __builtin_amdgcn_exp2f(S[jt][i + 1]); ls2 = ls2 + t; S[jt][i] = t[0]; S[jt][i + 1] = t[1]; } \
              __builtin_amdgcn_sched_barrier(0); } } \
        l += ls2[0] + ls2[1]; \
        { const LAS bf16_t* Vc = Vt + (p_) * VB_ + vtr; bf16x8 vf[8]; \
          _Pragma("unroll") for (int f_ = 0; f_ < 8; ++f_) { const LAS bf16_t* vp = Vc + (16 * (f_ >> 1)) * 72 + 32 * (f_ & 1); vf[f_] = cat4(trr(vp), trr(vp + 8 * 72)); }     \
          bf16x8 pf[4]; _Pragma("unroll") for (int f_ = 0; f_ < 4; ++f_) pf[f_] = pack8(S[f_ >> 1], f_ & 1); \
          __builtin_amdgcn_sched_barrier(0); \
          _Pragma("unroll") for (int f_ = 0; f_ < 8; ++f_) accO[f_ & 1] = MFMA32(vf[f_], pf[f_ >> 1], accO[f_ & 1]); } \
        S[0] = Sn[0]; S[1] = Sn[1]; \
        STOREK(it + 2, (p_), kSt); STOREV(it + 1, (p_) ^ 1, vSt); \
        __syncthreads(); } while (0)
    u32x4 kA = {0u, 0u, 0u, 0u}, vA = kA, kB = kA, vB = kA;
    f32x16 S[2];
    { u32x4 k0 = kA, k1 = kA, v0 = kA; LOADK(0, k0); LOADV(0, v0); LOADK(1, k1); LOADK(2, kA); LOADV(1, vA);
      STOREK(0, 0, k0); STOREV(0, 0, v0); STOREK(1, 1, k1); }
    __syncthreads();
    QK(S, 0);
    __syncthreads();
    for (int it2 = 0; it2 < ntiles; it2 += 2) {
        TILE_STEP(it2, 0, kB, vB, kA, vA);
        if (it2 + 1 < ntiles) TILE_STEP(it2 + 1, 1, kA, vA, kB, vB);
    }
#undef TILE_KEY
#undef LOADK
#undef LOADV
#undef STOREK
#undef STOREV
#undef QK
#undef TILE_STEP
    l += __shfl_xor(l, 32);
    const float il = 1.f / l;
    bf16_t* op = O + (Rb + tq) * D + (mix ? 256 : 0) + head * 64;
    u32x2 og[8];
#pragma unroll
    for (int nt = 0; nt < 2; ++nt)
#pragma unroll
        for (int g4 = 0; g4 < 4; ++g4) { og[4 * nt + g4].x = pk2(accO[nt][4 * g4] * il, accO[nt][4 * g4 + 1] * il); og[4 * nt + g4].y = pk2(accO[nt][4 * g4 + 2] * il, accO[nt][4 * g4 + 3] * il); }
    store_row8(op, og, h);
}

DI void gla_out_item(const KP& P, int layer, int b, int tb, LAS unsigned char* lds) {
    const int tid = otid(P.wv), lane = tid & 63, wave = tid >> 6, r = lane & 31, h = lane >> 5;
    const bf16_t* Z = (const bf16_t*)(P.ws + WS_Z); const float* BG = (const float*)(P.ws + WS_BG);
    const bf16_t* SG = (const bf16_t*)(P.ws + WS_UGC); bf16_t* O = (bf16_t*)(P.ws + WS_O);
    const int hd = wave & 3, mh = wave >> 2, t0 = tb * 64, t = 32 * mh + r; const size_t R0 = (size_t)b * TT + t0;
    constexpr int QP = 136, VP = 272, BP = 260;
    LAS bf16_t* Qt = (LAS bf16_t*)lds; LAS bf16_t* Kt = (LAS bf16_t*)(lds + 17408); LAS bf16_t* Vt = (LAS bf16_t*)(lds + 34816); LAS float* Bt = (LAS float*)(lds + 69632);
    { u32x4 qv[2], kv[2], vv[4]; f32x4 bv[8];
#pragma unroll
      for (int i = 0; i < 2; ++i) { const int q = tid + 512 * i, row = q >> 4, ch = q & 15; qv[i] = ldg16(Z + (R0 + row) * ZW + C_QC + ch * 8); kv[i] = ldg16(Z + (R0 + row) * ZW + C_KC + ch * 8); }
#pragma unroll
      for (int i = 0; i < 4; ++i) { const int q = tid + 512 * i, row = q >> 5, ch = q & 31; vv[i] = ldg16(Z + (R0 + row) * ZW + C_VC + ch * 8); }
#pragma unroll
      for (int i = 0; i < 8; ++i) { const int q = tid + 512 * i, row = q >> 6, ch = q & 63; bv[i] = *(const f32x4*)(BG + (R0 + row) * 256 + ch * 4); }
#pragma unroll
      for (int i = 0; i < 2; ++i) { const int q = tid + 512 * i, row = q >> 4, ch = q & 15; *(LAS u32x4*)(Qt + row * QP + ch * 8) = qv[i]; *(LAS u32x4*)(Kt + row * QP + ch * 8) = kv[i]; }
#pragma unroll
      for (int i = 0; i < 4; ++i) { const int q = tid + 512 * i, row = q >> 5, ch = q & 31; *(LAS u32x4*)(Vt + row * VP + ch * 8) = vv[i]; }
#pragma unroll
      for (int i = 0; i < 8; ++i) { const int q = tid + 512 * i, row = q >> 6, ch = q & 63; *(LAS f32x4*)(Bt + row * BP + ch * 4) = bv[i]; } }
    __syncthreads();
    const int vtr = (4 * h + ((lane & 15) >> 2)) * VP + 16 * ((lane >> 4) & 1) + 4 * (lane & 3) + hd * 64;
    f32x16 accO[2]; accO[0] = zero16(); accO[1] = zero16();
#pragma unroll 1
    for (int dir = 0; dir < 2; ++dir) {
        const int c = dir ? (tb < 4 ? 3 - tb : 71 - tb) : tb, chain = (b * 2 + dir) * 4 + hd;
        const bf16_t* sgp = SG + ((size_t)chain * NTB + c) * 2048 + (size_t)r * 32 + 8 * h;
        u32x4 Sf[2][2];
#pragma unroll
        for (int nt = 0; nt < 2; ++nt)
#pragma unroll
            for (int kk = 0; kk < 2; ++kk) Sf[nt][kk] = ldg16(sgp + nt * 1024 + 16 * kk);
        bf16x8 Qf[2];
#pragma unroll
        for (int kk = 0; kk < 2; ++kk) { const int d0 = hd * 32 + 16 * kk + 8 * h; const u32x4 qv = *(const LAS u32x4*)(Qt + t * QP + d0);
            const LAS float* bp = Bt + t * BP + dir * 128 + d0; const f32x4 b0 = *(const LAS f32x4*)bp, b1 = *(const LAS f32x4*)(bp + 4);
            const float sc = 0.17677669529663687f;
            u32x4 o; o.x = pk2(bflo(qv.x) * __expf(b0[0]) * sc, bfhi(qv.x) * __expf(b0[1]) * sc); o.y = pk2(bflo(qv.y) * __expf(b0[2]) * sc, bfhi(qv.y) * __expf(b0[3]) * sc);
            o.z = pk2(bflo(qv.z) * __expf(b1[0]) * sc, bfhi(qv.z) * __expf(b1[1]) * sc); o.w = pk2(bflo(qv.w) * __expf(b1[2]) * sc, bfhi(qv.w) * __expf(b1[3]) * sc);
            Qf[kk] = as_bf8(o); }
#pragma unroll
        for (int jt = 0; jt < 2; ++jt) { f32x16 S = zero16();
#pragma unroll
            for (int kk = 0; kk < 2; ++kk) { const int d0 = hd * 32 + 16 * kk + 8 * h; const u32x4 kv = *(const LAS u32x4*)(Kt + (32 * jt + r) * QP + d0);
                const LAS float* bp = Bt + (32 * jt + r) * BP + dir * 128 + d0; const f32x4 b0 = *(const LAS f32x4*)bp, b1 = *(const LAS f32x4*)(bp + 4);
                u32x4 o; o.x = pk2(bflo(kv.x) * __expf(-b0[0]), bfhi(kv.x) * __expf(-b0[1])); o.y = pk2(bflo(kv.y) * __expf(-b0[2]), bfhi(kv.y) * __expf(-b0[3]));
                o.z = pk2(bflo(kv.z) * __expf(-b1[0]), bfhi(kv.z) * __expf(-b1[1])); o.w = pk2(bflo(kv.w) * __expf(-b1[2]), bfhi(kv.w) * __expf(-b1[3]));
                S = MFMA32(as_bf8(o), Qf[kk], S); }
#pragma unroll
            for (int i = 0; i < 16; ++i) { const int s = 32 * jt + crow(i, h); const bool keep = dir ? (s >= t) : (s <= t); S[i] = keep ? S[i] : 0.f; }
            const bf16x8 Pf0 = pack8(S, 0), Pf1 = pack8(S, 1);
#pragma unroll
            for (int nt = 0; nt < 2; ++nt) { const LAS bf16_t* vp = Vt + vtr + (32 * jt) * VP + 32 * nt;
                accO[nt] = MFMA32(cat4(trr(vp), trr(vp + 8 * VP)), Pf0, accO[nt]);
                accO[nt] = MFMA32(cat4(trr(vp + 16 * VP), trr(vp + 24 * VP)), Pf1, accO[nt]); } }
#pragma unroll
        for (int nt = 0; nt < 2; ++nt)
#pragma unroll
            for (int kk = 0; kk < 2; ++kk) accO[nt] = MFMA32(as_bf8(Sf[nt][kk]), Qf[kk], accO[nt]);
    }
    float ss = 0.f;
#pragma unroll
    for (int nt = 0; nt < 2; ++nt)
#pragma unroll
        for (int i = 0; i < 16; ++i) ss += accO[nt][i] * accO[nt][i];
    ss += __shfl_xor(ss, 32);
    const float rstd = rsqrtf(ss * (1.f / 64.f) + EPS);
    u32x2 og[8];
#pragma unroll
    for (int nt = 0; nt < 2; ++nt)
#pragma unroll
        for (int g4 = 0; g4 < 4; ++g4) { const int dv = 32 * nt + 8 * g4 + 4 * h;
            const u32x2 rv = ldg8(Z + (R0 + t) * ZW + C_RC + hd * 64 + dv); const f32x4 gg = *(const f32x4*)(P.g_gla_out + layer * 64 + dv);
            const float rr[4] = {bflo(rv.x), bfhi(rv.x), bflo(rv.y), bfhi(rv.y)}; float y[4];
#pragma unroll
            for (int e = 0; e < 4; ++e) { const float sl = rr[e] / (1.f + __expf(-rr[e])); y[e] = accO[nt][4 * g4 + e] * rstd * gg[e] * sl; }
            og[4 * nt + g4].x = pk2(y[0], y[1]); og[4 * nt + g4].y = pk2(y[2], y[3]); }
    store_row8(O + (R0 + t) * D + 512 + hd * 64, og, h);
    __syncthreads();
}

DI void mlstm_out_item(const KP& P, int layer, int b, int tb, LAS unsigned char* lds) {
    const int tid = otid(P.wv), lane = tid & 63, wave = tid >> 6, r = lane & 31, h = lane >> 5;
    const bf16_t* Z = (const bf16_t*)(P.ws + WS_Z); const float* FG = (const float*)(P.ws + WS_FG); const float* IG = (const float*)(P.ws + WS_IG);
    const bf16_t* SG = (const bf16_t*)(P.ws + WS_UGD); const float* NP = (const float*)(P.ws + WS_NGD); bf16_t* O = (bf16_t*)(P.ws + WS_O);
    const int hd = wave & 3, mh = wave >> 2, t0 = tb * 64, t = 32 * mh + r; const size_t R0 = (size_t)b * TT + t0;
    constexpr int QP = 264, VP = 272;
    LAS bf16_t* Qt = (LAS bf16_t*)lds; LAS bf16_t* Kt = (LAS bf16_t*)(lds + 33792); LAS bf16_t* Vt = (LAS bf16_t*)(lds + 67584);
    LAS float* Fs = (LAS float*)(lds + 102400); LAS float* As = Fs + 512;
    { u32x4 qv[4], kv[4], vv[4];
#pragma unroll
      for (int i = 0; i < 4; ++i) { const int q = tid + 512 * i, row = q >> 5, ch = q & 31; const bf16_t* zr = Z + (R0 + row) * ZW + ch * 8;
          qv[i] = ldg16(zr + C_QD); kv[i] = ldg16(zr + C_KD); vv[i] = ldg16(zr + C_VD); }
      f32x4 gv = {0.f, 0.f, 0.f, 0.f};
      if (tid < 128) gv = *(const f32x4*)(FG + R0 * 8 + tid * 4); else if (tid < 256) gv = *(const f32x4*)(IG + R0 * 8 + (tid - 128) * 4);
#pragma unroll
      for (int i = 0; i < 4; ++i) { const int q = tid + 512 * i, row = q >> 5, ch = q & 31;
          *(LAS u32x4*)(Qt + row * QP + ch * 8) = qv[i]; *(LAS u32x4*)(Kt + row * QP + ch * 8) = kv[i]; *(LAS u32x4*)(Vt + row * VP + ch * 8) = vv[i]; }
      if (tid < 256) *(LAS f32x4*)(Fs + tid * 4) = gv; }
    __syncthreads();
    bf16x8 Qf[4];
#pragma unroll
    for (int kk = 0; kk < 4; ++kk) Qf[kk] = *(const LAS bf16x8*)(Qt + t * QP + hd * 64 + 16 * kk + 8 * h);
    f32x16 S[2];
#pragma unroll
    for (int jt = 0; jt < 2; ++jt) { S[jt] = zero16();
#pragma unroll
        for (int kk = 0; kk < 4; ++kk) S[jt] = MFMA32(*(const LAS bf16x8*)(Kt + (32 * jt + r) * QP + hd * 64 + 16 * kk + 8 * h), Qf[kk], S[jt]); }
    const int vtr = (4 * h + ((lane & 15) >> 2)) * VP + 16 * ((lane >> 4) & 1) + 4 * (lane & 3) + hd * 64;
    f32x16 hs[2]; hs[0] = zero16(); hs[1] = zero16();
#pragma unroll 1
    for (int dir = 0; dir < 2; ++dir) {
        const int c = dir ? (tb < 4 ? 3 - tb : 71 - tb) : tb, chain = (b * 2 + dir) * 4 + hd, gi = dir * 4 + hd;
        const bf16_t* sgp = SG + ((size_t)chain * NTB + c) * 4096 + (size_t)r * 64 + 8 * h;
        f32x16 aI[2];
#pragma unroll
        for (int nt = 0; nt < 2; ++nt) { aI[nt] = zero16();
#pragma unroll
            for (int kk = 0; kk < 4; ++kk) aI[nt] = MFMA32(as_bf8(ldg16(sgp + nt * 2048 + 16 * kk)), Qf[kk], aI[nt]); }
        const float* np = NP + ((size_t)chain * NTB + c) * 64;
        float qn = 0.f;
#pragma unroll
        for (int kk = 0; kk < 4; ++kk) { const f32x4 n0 = *(const f32x4*)(np + 16 * kk + 8 * h), n1 = *(const f32x4*)(np + 16 * kk + 8 * h + 4); const u32x4 qv = __builtin_bit_cast(u32x4, Qf[kk]);
            qn += bflo(qv.x) * n0[0] + bfhi(qv.x) * n0[1] + bflo(qv.y) * n0[2] + bfhi(qv.y) * n0[3] + bflo(qv.z) * n1[0] + bfhi(qv.z) * n1[1] + bflo(qv.w) * n1[2] + bfhi(qv.w) * n1[3]; }
        qn += __shfl_xor(qn, 32);
        const float Ft = Fs[t * 8 + gi];
        float den = 0.f;
        f32x16 aP[2]; aP[0] = zero16(); aP[1] = zero16();
#pragma unroll
        for (int jt = 0; jt < 2; ++jt) { f32x16 Pv;
#pragma unroll
            for (int i = 0; i < 16; ++i) { const int s = 32 * jt + crow(i, h); const bool keep = dir ? (s >= t) : (s <= t);
                const float as = As[s * 8 + gi];
                const float pe = keep ? S[jt][i] * (__expf(Ft + as) * 0.125f) : 0.f; Pv[i] = pe; den += pe; }
            const bf16x8 Pf0 = pack8(Pv, 0), Pf1 = pack8(Pv, 1);
#pragma unroll
            for (int nt = 0; nt < 2; ++nt) { const LAS bf16_t* vp = Vt + vtr + (32 * jt) * VP + 32 * nt;
                aP[nt] = MFMA32(cat4(trr(vp), trr(vp + 8 * VP)), Pf0, aP[nt]);
                aP[nt] = MFMA32(cat4(trr(vp + 16 * VP), trr(vp + 24 * VP)), Pf1, aP[nt]); } }
        den += __shfl_xor(den, 32);
        const float ef = __expf(Ft), dtot = den + ef * qn, inv = 1.f / fmaxf(fabsf(dtot), 1.f);
#pragma unroll
        for (int nt = 0; nt < 2; ++nt) hs[nt] = hs[nt] + (aP[nt] + aI[nt] * ef) * inv;
    }
    float ss = 0.f;
#pragma unroll
    for (int nt = 0; nt < 2; ++nt)
#pragma unroll
        for (int i = 0; i < 16; ++i) ss += hs[nt][i] * hs[nt][i];
    ss += __shfl_xor(ss, 32);
    const float rstd = rsqrtf(ss * (1.f / 64.f) + EPS);
    u32x2 og[8];
#pragma unroll
    for (int nt = 0; nt < 2; ++nt)
#pragma unroll
        for (int g4 = 0; g4 < 4; ++g4) { const int dv = 32 * nt + 8 * g4 + 4 * h;
            const u32x2 ov = ldg8(Z + (R0 + t) * ZW + C_OD + hd * 64 + dv); const f32x4 gg = *(const f32x4*)(P.g_mlstm_out + layer * 64 + dv);
            const float oo[4] = {bflo(ov.x), bfhi(ov.x), bflo(ov.y), bfhi(ov.y)}; float y[4];
#pragma unroll
            for (int e = 0; e < 4; ++e) { const float sg = 1.f / (1.f + __expf(-oo[e])); y[e] = hs[nt][4 * g4 + e] * rstd * gg[e] * sg; }
            og[4 * nt + g4].x = pk2(y[0], y[1]); og[4 * nt + g4].y = pk2(y[2], y[3]); }
    store_row8(O + (R0 + t) * D + 768 + hd * 64, og, h);
    __syncthreads();
}

DI void mixer_phase(const KP& P, int layer, LAS unsigned char* lds) {
    const int G = gridDim.x, bx = blockIdx.x;
    const int n_scan = layer == 0 ? NB * NTB : NB * 64;
    for (int r = bx; r < 512; r += G) { const int b = r >> 6, g = (r >> 5) & 1, qb = r & 31; attn_item(P, layer, 0, b, g, CTX + qb * 128, 4, NTB, 0, lds); }
    for (int r = bx; r < 512; r += G) { const int b = r >> 6, g = (r >> 5) & 1, qb = r & 31; const int qt = 4 + 2 * qb; int lo = qt - 2, hi = qt + 4; if (lo < 4) lo = 4; if (hi > NTB) hi = NTB;
        attn_item(P, layer, 1, b, g, CTX + qb * 128, lo, hi, 1, lds); }
    if (layer == 0) for (int r = rot((int)bx, 64, G); r < 64; r += G) { const int mix = r >> 5, b = (r >> 2) & 7, g = (r >> 1) & 1, qb = r & 1; attn_item(P, layer, mix, b, g, qb * 128, 4, 4, 0, lds); }
    for (int rr = rot((int)bx, 128, G); rr < n_scan; rr += G) { int b, tb; if (layer == 0) { b = rr / NTB; tb = rr % NTB; } else { b = rr >> 6; tb = 4 + (rr & 63); } mlstm_out_item(P, layer, b, tb, lds); }
    for (int rr = rot((int)bx, 96, G); rr < n_scan; rr += G) { int b, tb; if (layer == 0) { b = rr / NTB; tb = rr % NTB; } else { b = rr >> 6; tb = 4 + (rr & 63); } gla_out_item(P, layer, b, tb, lds); }
}

#define XB_TMO      128
#define XB_XCNT(j)  (256  + 64 * (j))
#define XB_XSUB(j)  (1280 + 64 * (j))
#define XB_XGEN(j)  (2304 + 64 * (j))
#define XB_TOP      3328
#define XB_TOPGEN   3392
#define XCD_BAR_WORDS 3456
#define XB_SPIN_CAP (1u << 22)
DI unsigned xb_ld(unsigned* p)              { return __hip_atomic_load(p, __ATOMIC_RELAXED, __HIP_MEMORY_SCOPE_AGENT); }
DI unsigned xb_add(unsigned* p, unsigned v) { return __hip_atomic_fetch_add(p, v, __ATOMIC_RELAXED, __HIP_MEMORY_SCOPE_AGENT); }
DI unsigned xb_xcc_id() { return (unsigned)__builtin_amdgcn_s_getreg((3 << 11) | 20) & 0xFu; }
#define XB_SPIN(cond, bar) do { unsigned _sp = 0; while (cond) { __builtin_amdgcn_s_sleep(1); \
    if ((++_sp & 255u) == 0u) { if (xb_ld(&(bar)[XB_TMO])) break; if (_sp > XB_SPIN_CAP) { atomicAdd(&(bar)[XB_TMO], 1u); break; } } } } while (0)
struct XcdBarrier { unsigned* bar; unsigned x; volatile LAS unsigned* st; };
DI XcdBarrier xcd_barrier_post(unsigned* bar, volatile LAS unsigned* st, bool t0) {
    XcdBarrier b; b.bar = bar; b.x = xb_xcc_id(); b.st = st;
    if (t0) (void)xb_add(&bar[XB_XCNT(b.x)], 1u);
    return b;
}
DI void xcd_barrier_complete(unsigned* bar, unsigned x, unsigned& nloc, unsigned& nx) {
    const unsigned G = gridDim.x;
    unsigned sum, cnt, mine, sp = 0u;
    for (;;) {
        sum = 0u; cnt = 0u; mine = 0u;
#pragma unroll
        for (unsigned j = 0; j < 16; ++j) { const unsigned c = xb_ld(&bar[XB_XCNT(j)]); sum += c; cnt += (c > 0u) ? 1u : 0u; mine = (j == x) ? c : mine; }
        if (sum == G) break;
        __builtin_amdgcn_s_sleep(1);
        if ((++sp & 255u) == 0u) { if (xb_ld(&bar[XB_TMO])) break; if (sp > XB_SPIN_CAP) { atomicAdd(&bar[XB_TMO], 1u); break; } }
    }
    nloc = mine > 0u ? mine : 1u; nx = cnt > 0u ? cnt : 1u;
}
DI void xcd_barrier(const XcdBarrier& b, int wv) {
    asm volatile("s_waitcnt vmcnt(0)" ::: "memory");
    __syncthreads();
    if (otid(wv) == 0) {
        unsigned* bar = b.bar;
        __builtin_amdgcn_s_waitcnt(0);
        unsigned nloc = b.st[0], nx = b.st[1];
        if (nloc == 0u) { xcd_barrier_complete(bar, b.x, nloc, nx); b.st[0] = nloc; b.st[1] = nx; }
        const unsigned old = xb_add(&bar[XB_XSUB(b.x)], 1u);
        const unsigned gen = old / nloc;
        if (old + 1u == (gen + 1u) * nloc) {
            __builtin_amdgcn_fence(__ATOMIC_RELEASE, "agent");
            asm volatile("s_waitcnt vmcnt(0)" ::: "memory");
            const unsigned og = xb_add(&bar[XB_TOP], 1u);
            const unsigned tg = og / nx;
            if (og + 1u == (tg + 1u) * nx) xb_add(&bar[XB_TOPGEN], 1u);
            else XB_SPIN(xb_ld(&bar[XB_TOPGEN]) == tg, bar);
            __builtin_amdgcn_fence(__ATOMIC_ACQUIRE, "agent");
            xb_add(&bar[XB_XGEN(b.x)], 1u);
            asm volatile("s_waitcnt vmcnt(0)" ::: "memory");
        } else {
            XB_SPIN(xb_ld(&bar[XB_XGEN(b.x)]) == gen, bar);
            __builtin_amdgcn_fence(__ATOMIC_ACQUIRE, "agent");
            asm volatile("s_waitcnt vmcnt(0)" ::: "memory");
        }
    }
    __syncthreads();
}

__global__ void __launch_bounds__(512, 2) fwd_megakernel(Params Pin) {
    KP P; (Params&)P = Pin; P.wv = __builtin_amdgcn_readfirstlane((int)threadIdx.x >> 6);
    extern __shared__ __attribute__((aligned(16))) unsigned char lds_raw[];
    LAS unsigned char* lds = (LAS unsigned char*)lds_raw;
    cg::grid_group grid = cg::this_grid();
    const int G = gridDim.x, bx = blockIdx.x;
    const float* MOD = (const float*)(P.ws + WS_MOD);
    volatile LAS unsigned* xst = (volatile LAS unsigned*)(lds + LDS_BYTES - 16);
    unsigned* barw = (unsigned*)(P.ws + WS_BAR);
    { const int t = otid(P.wv); if (t == 0) { xst[0] = 0u; xst[1] = 0u; }
      if (bx == 0) for (int i = t; i < XCD_BAR_WORDS; i += 512) barw[i] = 0u; }
    p0_phase(P, lds, 0);
    grid.sync();
    const XcdBarrier xb = xcd_barrier_post(barw, xst, otid(P.wv) == 0);
#define GSYNC() xcd_barrier(xb, P.wv)
    for (int layer = 0; layer < 2; ++layer) {
        const int skip = layer == 1;
        norm_phase(P, layer, 1, 0);
        GSYNC();
        { pg8::Gemm g{(const bf16_t*)(P.ws + WS_H), (const bf16_t*)(P.ws + WS_WIN) + (size_t)layer * ZW * D, D}; pg8::Order S; S.init(ZW / 256, G, bx, 0, D);
          pg8::EpiZ E{(bf16_t*)(P.ws + WS_Z), (float*)(P.ws + WS_GATE)}; pg8::gemm_phase(lds, g, S, E, P.wv); }
        GSYNC();
        prep_phase(P, layer, lds);
        GSYNC();
        chain_phase(P);
        if (layer == 0) p0_phase(P, lds, 1);
        GSYNC();
        mixer_phase(P, layer, lds);
        GSYNC();
        { pg8::Gemm g{(const bf16_t*)(P.ws + WS_O), (const bf16_t*)(P.ws + WS_WOUT) + (size_t)layer * D * D, D}; pg8::Order S; S.init(D / 256, G, bx, 1, D, layer == 0 ? 4 : 0);
          pg8::EpiRes E{P, layer == 0, MOD + (size_t)layer * 9 * 6144 + 2048}; pg8::gemm_phase(lds, g, S, E, P.wv); }
        GSYNC();
        norm_phase(P, layer, 2, skip);
        GSYNC();
        { pg8::Gemm g{(const bf16_t*)(P.ws + WS_H), (const bf16_t*)(P.ws + WS_W1) + (size_t)layer * FF * D, D}; pg8::Order S; S.init(FF / 256, G, bx, skip, D);
          pg8::EpiRelu2 E{(bf16_t*)(P.ws + WS_U1)}; pg8::gemm_phase(lds, g, S, E, P.wv); }
        GSYNC();
        { pg8::Gemm g{(const bf16_t*)(P.ws + WS_U1), (const bf16_t*)(P.ws + WS_W2) + (size_t)layer * D * FF, FF}; pg8::Order S; S.init(D / 256, G, bx, 1, FF, layer == 0 ? 8 : 0);
          pg8::EpiRes E{P, 0, MOD + (size_t)layer * 9 * 6144 + 5120}; pg8::gemm_phase(lds, g, S, E, P.wv); }
        if (layer == 0) GSYNC();
    }
}

extern "C" void kernel_launch(void* const* d_in, const int* in_sizes, int n_in, void* d_out, int out_size, void* d_ws, size_t ws_size, hipStream_t stream) {
    static int grid_blocks = 0;
    if (grid_blocks == 0) {
        if (n_in != 23 || ws_size < WS_END) { fprintf(stderr, "kernel_launch: unexpected n_in %d or ws_size %zu (need %zu)\n", n_in, ws_size, (size_t)WS_END); grid_blocks = -1; return; }
        int dev = 0, cus = 0, per_cu = 0;
        hipGetDevice(&dev);
        hipDeviceGetAttribute(&cus, hipDeviceAttributeMultiprocessorCount, dev);
        hipFuncSetAttribute((const void*)fwd_megakernel, hipFuncAttributeMaxDynamicSharedMemorySize, LDS_BYTES);
        hipOccupancyMaxActiveBlocksPerMultiprocessor(&per_cu, (const void*)fwd_megakernel, 512, LDS_BYTES);
        (void)per_cu;
        grid_blocks = cus;
        (void)hipGetLastError();
    }
    if (grid_blocks < 0) return;
    Params p{};
    const float** pp = (const float**)&p;
    for (int i = 0; i < 23; ++i) pp[i] = (const float*)d_in[i];
    p.out = (float*)d_out; p.ws = (unsigned char*)d_ws;
    void* args[] = {&p};
    hipError_t e = hipLaunchCooperativeKernel((const void*)fwd_megakernel, dim3(grid_blocks), dim3(512), args, LDS_BYTES, stream);
    if (e != hipSuccess) fprintf(stderr, "cooperative launch failed: %s (grid %d)\n", hipGetErrorString(e), grid_blocks);
}
```
